# Optimizing an MI355X kernel written in HIP

```python
import math
import jax, jax.numpy as jnp
from jax import lax
import numpy as np

D_MODEL = 1024
BATCH = 2
SEQ = 16384
DEPTH = 1
DEC_BATCH = 8
DEC_SEQ = 8192
PAST_LEN = 128

D_ATTN = D_MODEL // 2
D_SSM = D_MODEL - D_ATTN
HEAD_DIM = 64
N_HEADS = D_ATTN // HEAD_DIM
ROT_DIM = HEAD_DIM // 4
ROPE_THETA = 500000.0
DILATED_BRANCHES = ((128, 1), (512, 4), (2048, 16))
MAX_HALF = max(w // 2 for w, _ in DILATED_BRANCHES)
Q_BLOCK = 128
NEG_INF = -1e30
SSM_GROUP = 16
N_SSM_GROUPS = D_SSM // SSM_GROUP
SSM_STATE = 64
D_FF = 2816
CONV_WIDTH = 3
DN_ALPHA = (2 * DEPTH) ** 0.25
DN_BETA = (8 * DEPTH) ** -0.25
LN_EPS = 1e-5

kernel_name = "hybrid_dilated_attn_s5_encoder"


def layer_norm(x, g, b):
    xf = x.astype(jnp.float32)
    mu = jnp.mean(xf, axis=-1, keepdims=True)
    var = jnp.mean(jnp.square(xf - mu), axis=-1, keepdims=True)
    return (xf - mu) * lax.rsqrt(var + LN_EPS) * g.astype(jnp.float32) + b.astype(jnp.float32)


def rms_norm(x, g):
    xf = x.astype(jnp.float32)
    return xf * lax.rsqrt(jnp.mean(jnp.square(xf), axis=-1, keepdims=True) + LN_EPS) * g.astype(jnp.float32)


def partial_rope(x):
    S = x.shape[1]
    half = ROT_DIM // 2
    inv_freq = ROPE_THETA ** (-jnp.arange(half, dtype=jnp.float32) * 2.0 / ROT_DIM)
    ang = jnp.arange(S, dtype=jnp.float32)[:, None] * inv_freq[None, :]
    cos = jnp.cos(ang)[None, :, None, :]
    sin = jnp.sin(ang)[None, :, None, :]
    x1 = x[..., :half]
    x2 = x[..., half:ROT_DIM]
    return jnp.concatenate([x1 * cos - x2 * sin, x2 * cos + x1 * sin, x[..., ROT_DIM:]], axis=-1)


def dilated_attention(q, k, v):
    B, S, H, Dh = q.shape
    scale = Dh ** -0.5
    pad = ((0, 0), (MAX_HALF, MAX_HALF), (0, 0), (0, 0))
    kp = jnp.pad(k, pad)
    vp = jnp.pad(v, pad)
    rows = jnp.arange(Q_BLOCK)

    def block(s0):
        qb = lax.dynamic_slice_in_dim(q, s0, Q_BLOCK, axis=1)
        outs, lses = [], []
        for window, dil in DILATED_BRANCHES:
            n_side = window // (2 * dil)
            offs = jnp.arange(-n_side, n_side + 1) * dil
            pos = s0 + rows[:, None] + offs[None, :]
            valid = (pos >= 0) & (pos < S)
            kg = jnp.take(kp, pos + MAX_HALF, axis=1)
            vg = jnp.take(vp, pos + MAX_HALF, axis=1)
            s = jnp.einsum('bqhd,bqkhd->bhqk', qb, kg) * scale
            s = jnp.where(valid[None, None], s, NEG_INF)
            m = jnp.max(s, axis=-1, keepdims=True)
            e = jnp.exp(s - m)
            den = jnp.sum(e, axis=-1, keepdims=True)
            outs.append(jnp.einsum('bhqk,bqkhd->bqhd', e / den, vg))
            lses.append((m + jnp.log(den))[..., 0])
        wts = jax.nn.softmax(jnp.stack(lses), axis=0)
        wts = jnp.transpose(wts, (0, 1, 3, 2))[..., None]
        return jnp.sum(jnp.stack(outs) * wts, axis=0)

    starts = jnp.arange(S // Q_BLOCK) * Q_BLOCK
    out = lax.map(block, starts)
    return jnp.transpose(out, (1, 0, 2, 3, 4)).reshape(B, S, H, Dh)


def _ssm_combine(e1, e2):
    a1, b1 = e1
    a2, b2 = e2
    return a2 * a1, a2 * b1 + b2


def bidirectional_s5(u, a_re, a_im, log_dt, b_re, b_im, c_re, c_im, d_skip):
    Bsz, S, _ = u.shape
    f32 = jnp.float32
    ug = u.reshape(Bsz, S, N_SSM_GROUPS, SSM_GROUP)
    lam = lax.complex(a_re.astype(f32), a_im.astype(f32))
    dt = jnp.exp(log_dt.astype(f32))[..., None]
    lam_bar = jnp.exp(lam * dt)
    b_bar = ((lam_bar - 1.0) / lam)[..., None] * lax.complex(b_re.astype(f32), b_im.astype(f32))
    c_mat = lax.complex(c_re.astype(f32), c_im.astype(f32))

    def per_seq(us):
        bu = jnp.einsum('ngpc,sgc->nsgp', b_bar, us.astype(jnp.complex64))
        a = jnp.broadcast_to(lam_bar[:, None], bu.shape)
        _, h_f = lax.associative_scan(_ssm_combine, (a[0], bu[0]))
        _, h_b = lax.associative_scan(_ssm_combine, (a[1], bu[1]), reverse=True)
        return jnp.einsum('gcp,sgp->sgc', c_mat, h_f + h_b).real

    y = lax.map(per_seq, ug)
    return y.reshape(Bsz, S, D_SSM) + d_skip.astype(f32) * u


def centred_dwconv(h, w, b):
    S = h.shape[1]
    half = CONV_WIDTH // 2
    hp = jnp.pad(h, ((0, 0), (half, half), (0, 0)))
    out = hp[:, 0:S] * w[0]
    for i in range(1, CONV_WIDTH):
        out = out + hp[:, i:i + S] * w[i]
    return out + b


def encoder_layer(x, w_in, attn_norm_g, ssm_a_re, ssm_a_im, ssm_log_dt, ssm_b_re, ssm_b_im,
                  ssm_c_re, ssm_c_im, ssm_d, w_glu, b_glu, ssm_norm_g, w_out, ln1_g, ln1_b,
                  w_up, conv_w, conv_b, w_down, ln2_g, ln2_b):
    in_dtype = x.dtype
    B, S, _ = x.shape
    f32 = jnp.float32
    h = jnp.einsum('bsd,de->bse', x, w_in).astype(f32)
    q, k, v, u = jnp.split(h, [D_ATTN, 2 * D_ATTN, 3 * D_ATTN], axis=-1)
    q = partial_rope(q.reshape(B, S, N_HEADS, HEAD_DIM))
    k = partial_rope(k.reshape(B, S, N_HEADS, HEAD_DIM))
    v = v.reshape(B, S, N_HEADS, HEAD_DIM)
    a = dilated_attention(q, k, v).reshape(B, S, D_ATTN)
    s = bidirectional_s5(u, ssm_a_re, ssm_a_im, ssm_log_dt, ssm_b_re, ssm_b_im,
                         ssm_c_re, ssm_c_im, ssm_d)
    s = jax.nn.gelu(s)
    s = s * jax.nn.sigmoid(s @ w_glu.astype(f32) + b_glu.astype(f32))
    mix = jnp.concatenate([rms_norm(a, attn_norm_g), rms_norm(s, ssm_norm_g)], axis=-1)
    mix = jnp.einsum('bse,ed->bsd', mix.astype(in_dtype), w_out)
    x = layer_norm(DN_ALPHA * x.astype(f32) + mix.astype(f32), ln1_g, ln1_b).astype(in_dtype)
    up = jnp.einsum('bsd,df->bsf', x, w_up)
    gate, val = jnp.split(up, 2, axis=-1)
    gate = centred_dwconv(gate, conv_w, conv_b)
    f = (jax.nn.gelu(gate.astype(f32)) * val.astype(f32)).astype(in_dtype)
    ff = jnp.einsum('bsf,fd->bsd', f, w_down)
    x = layer_norm(DN_ALPHA * x.astype(f32) + ff.astype(f32), ln2_g, ln2_b).astype(in_dtype)
    return x


def setup_inputs(seed: int = 0) -> dict:
    key = jax.random.key(seed)
    ks = jax.random.split(key, 24)
    L, G, P, C = DEPTH, N_SSM_GROUPS, SSM_STATE, SSM_GROUP
    f32 = jnp.float32

    def nrm(k, shape, scale):
        return scale * jax.random.normal(k, shape, f32)

    n_idx = jnp.arange(P, dtype=f32)
    return {
        "x_prompt": nrm(ks[0], (BATCH, SEQ, D_MODEL), 1.0),
        "x_sample": nrm(ks[1], (DEC_BATCH, DEC_SEQ, D_MODEL), 1.0),
        "w_in": nrm(ks[2], (L, D_MODEL, 3 * D_ATTN + D_SSM), D_MODEL ** -0.5),
        "attn_norm_g": 1.0 + nrm(ks[3], (L, D_ATTN), 0.02),
        "ssm_a_re": -0.5 + nrm(ks[4], (L, 2, G, P), 0.01),
        "ssm_a_im": math.pi * n_idx + nrm(ks[5], (L, 2, G, P), 0.01),
        "ssm_log_dt": jax.random.uniform(ks[6], (L, 2, G), f32, math.log(1e-3), math.log(1e-1)),
        "ssm_b_re": nrm(ks[7], (L, 2, G, P, C), (2 * C) ** -0.5),
        "ssm_b_im": nrm(ks[8], (L, 2, G, P, C), (2 * C) ** -0.5),
        "ssm_c_re": nrm(ks[9], (L, G, C, P), P ** -0.5),
        "ssm_c_im": nrm(ks[10], (L, G, C, P), P ** -0.5),
        "ssm_d": nrm(ks[11], (L, D_SSM), 1.0),
        "w_glu": nrm(ks[12], (L, D_SSM, D_SSM), D_SSM ** -0.5),
        "b_glu": nrm(ks[13], (L, D_SSM), 0.01),
        "ssm_norm_g": 1.0 + nrm(ks[14], (L, D_SSM), 0.02),
        "w_out": nrm(ks[15], (L, D_MODEL, D_MODEL), DN_BETA * D_MODEL ** -0.5),
        "ln1_g": 1.0 + nrm(ks[16], (L, D_MODEL), 0.02),
        "ln1_b": nrm(ks[17], (L, D_MODEL), 0.02),
        "w_up": nrm(ks[18], (L, D_MODEL, 2 * D_FF), D_MODEL ** -0.5),
        "conv_w": nrm(ks[19], (L, CONV_WIDTH, D_FF), CONV_WIDTH ** -0.5),
        "conv_b": nrm(ks[20], (L, D_FF), 0.01),
        "w_down": nrm(ks[21], (L, D_FF, D_MODEL), DN_BETA * D_FF ** -0.5),
        "ln2_g": 1.0 + nrm(ks[22], (L, D_MODEL), 0.02),
        "ln2_b": nrm(ks[23], (L, D_MODEL), 0.02),
    }


def reference(x_prompt, x_sample, w_in, attn_norm_g, ssm_a_re, ssm_a_im, ssm_log_dt, ssm_b_re,
              ssm_b_im, ssm_c_re, ssm_c_im, ssm_d, w_glu, b_glu, ssm_norm_g, w_out, ln1_g, ln1_b,
              w_up, conv_w, conv_b, w_down, ln2_g, ln2_b):
    y_prompt = x_prompt
    y_sample = x_sample
    for l in range(DEPTH):
        params = (w_in[l], attn_norm_g[l], ssm_a_re[l], ssm_a_im[l], ssm_log_dt[l], ssm_b_re[l],
                  ssm_b_im[l], ssm_c_re[l], ssm_c_im[l], ssm_d[l], w_glu[l], b_glu[l],
                  ssm_norm_g[l], w_out[l], ln1_g[l], ln1_b[l], w_up[l], conv_w[l], conv_b[l],
                  w_down[l], ln2_g[l], ln2_b[l])
        y_prompt = encoder_layer(y_prompt, *params)
        y_sample = encoder_layer(y_sample, *params)
    return (y_prompt, y_sample)
```

```cpp
#include <hip/hip_runtime.h>
#include <hip/hip_cooperative_groups.h>
#include <cstdio>
#include <cstdint>
namespace cg = cooperative_groups;

#define LAS __attribute__((address_space(3)))
typedef unsigned short bf16_t;
typedef short bf16x8 __attribute__((ext_vector_type(8)));
typedef short bf16x4 __attribute__((ext_vector_type(4)));
typedef float f32x4 __attribute__((ext_vector_type(4)));
typedef float f32x2 __attribute__((ext_vector_type(2)));
typedef unsigned u32x4 __attribute__((ext_vector_type(4)));
typedef unsigned u32x2 __attribute__((ext_vector_type(2)));

constexpr int M = 98304, D = 1024, NIN = 2048, DH = 512, FF = 2816, NUP = 5632;
constexpr int MP = 32768;
constexpr int NCHUNK = M / 64;
constexpr float LN_EPS = 1e-5f;
constexpr float DN_ALPHA = 1.189207115002721f;
constexpr int UP_TM = 252;
constexpr int UP_NM = (M + UP_TM - 1) / UP_TM;

constexpr size_t MiB = 1u << 20;
constexpr size_t WS_STATS = 0;
constexpr size_t WS_ROPEC = 3 * MiB, WS_ROPES = WS_ROPEC + 16384 * 8 * 4;
constexpr size_t WS_LAM = 4 * MiB + 0;
constexpr size_t WS_LAML = WS_LAM + 32768;
constexpr size_t WS_BFRAG = WS_LAML + 32768;
constexpr size_t WS_CFRAG = WS_BFRAG + 262144;
constexpr size_t WS_GW = WS_CFRAG + 131072;
constexpr size_t WS_BW = WS_GW + 32768;
constexpr size_t WS_WIN = 5 * MiB;
constexpr size_t WS_WGLU = 9 * MiB;
constexpr size_t WS_WOUT = 10 * MiB;
constexpr size_t WS_WUP = 12 * MiB;
constexpr size_t WS_WDN = 24 * MiB;
constexpr size_t WS_A = 32 * MiB;
constexpr size_t WS_XB = WS_A, WS_Q = WS_A + 192 * MiB, WS_K = WS_Q + 96 * MiB, WS_V = WS_K + 96 * MiB, WS_U = WS_V + 96 * MiB;
constexpr size_t WS_YF = WS_XB;
constexpr size_t WS_SPRE = WS_Q;
constexpr size_t WS_F = WS_A;
constexpr size_t WS_MIX = WS_A + 576 * MiB;
constexpr size_t WS_Y1B = WS_MIX + 192 * MiB + 1 * MiB;
constexpr size_t WS_ST = WS_Y1B;
constexpr size_t WS_END = WS_Y1B + 192 * MiB + 1 * MiB;
static_assert(WS_END <= 1024 * MiB, "workspace map must fit 1 GiB");

__device__ __forceinline__ unsigned cvt_pk_bf16(float lo, float hi) { unsigned r; asm volatile("v_cvt_pk_bf16_f32 %0, %1, %2" : "=v"(r) : "v"(lo), "v"(hi)); return r; }
__device__ __forceinline__ float bf_lo(unsigned w) { return __uint_as_float(w << 16); }
__device__ __forceinline__ float bf_hi(unsigned w) { return __uint_as_float(w & 0xffff0000u); }
__device__ __forceinline__ float fast_exp2(float x) { return __builtin_amdgcn_exp2f(x); }
__device__ __forceinline__ float fast_rcp(float x) { return __builtin_amdgcn_rcpf(x); }
__device__ __forceinline__ float gelu_tanh(float x) {
    const float u = x * (1.0f + 0.044715f * x * x);
    const float e = fast_exp2(u * (-2.0f * 0.7978845608028654f * 1.4426950408889634f));
    return x * fast_rcp(1.0f + e);
}
__device__ __forceinline__ float sigmoidf_(float z) { return fast_rcp(1.0f + fast_exp2(-1.4426950408889634f * z)); }
__device__ __forceinline__ int row_pos(int row) { return row < MP ? (row & 16383) : (row & 8191); }
__device__ __forceinline__ int row_slen(int row) { return row < MP ? 16384 : 8192; }
template <int CTRL> __device__ __forceinline__ float dpp_f(float v) { return __int_as_float(__builtin_amdgcn_update_dpp(0, __float_as_int(v), CTRL, 0xF, 0xF, false)); }

struct Params {
    const float* in[24];
    float* out;
    unsigned char* ws;
};

namespace pg8 {
constexpr int BM = 256, BK = 64, HALF = 128, HTB = HALF * BK * 2, STAGE_BYTES = 8 * HTB, NXCD = 8, WGM = 8;
__device__ __forceinline__ int lds_byte(int r, int c) { const int st = (r >> 4) * 2 + (c >> 5), rr = r & 15, cc = c & 31, ob = rr * 64 + cc * 2; return st * 1024 + (ob ^ (((ob >> 9) & 1) << 5)); }
__device__ __forceinline__ void stage_rc(int b, int& R, int& C) { const int st = b / 1024, sb = b % 1024, swz = sb ^ (((sb >> 9) & 1) << 5); R = (st >> 1) * 16 + swz / 64; C = (st & 1) * 32 + (swz % 64) / 2; }
__device__ __forceinline__ int perm32(int rho) { const int n = rho >> 4, i = rho & 15; return 8 * (i >> 2) + 4 * n + (i & 3); }
struct Unit { int pm, pn; };
struct Gemm { const bf16_t* A; const bf16_t* Bt; int K; };
struct StaticOrder {
    int nM, nN, nwg, G, c;
    __device__ void init(int nM_, int nN_, int G_, int c_) { nM = nM_; nN = nN_; nwg = nM * nN; G = G_; c = c_; }
    __device__ bool next(int i, Unit& u) const {
        const long L = (long)i * G + c; if (L >= nwg) return false;
        int wgid = (int)L; { const int q = nwg / NXCD, r = nwg % NXCD, xcd = wgid % NXCD, off = wgid / NXCD; wgid = (xcd < r ? xcd * (q + 1) : r * (q + 1) + (xcd - r) * q) + off; }
        const int nig = WGM * nN, gid = wgid / nig, fm = gid * WGM, gsz = (nM - fm) < WGM ? (nM - fm) : WGM;
        u.pm = fm + ((wgid % nig) % gsz); u.pn = (wgid % nig) / gsz; return true;
    }
};

template <class Epi, int AMODE>
__device__ __forceinline__ void gemm_phase(LAS unsigned char* lds, const Gemm g, const StaticOrder& S, const Epi& E) {
    const int tid = threadIdx.x, wid = __builtin_amdgcn_readfirstlane(tid >> 6), lane = tid & 63, wr = wid >> 2, wc = wid & 3, fr = lane & 15, fq = lane >> 4;
    constexpr bool SPLIT2 = Epi::MID_T > 0;
    const int K = g.K, nt = SPLIT2 ? K / BK / 2 : K / BK;
    const size_t koff = (size_t)K;
    unsigned voffA[2], voffB[2];
#pragma unroll
    for (int i = 0; i < 2; ++i) { int R, C; stage_rc(tid * 16 + i * 8192, R, C); const int Rb = (R & ~31) + perm32(R & 31);
        const int Ra = AMODE ? (126 * (R >> 6) + (R & 63)) : R;
        voffA[i] = (unsigned)(Ra * K + C) * 2u; voffB[i] = (unsigned)(Rb * K + C) * 2u; }
    const size_t kstep = (size_t)(BK * 2);
    const size_t hstepB = (size_t)HALF * K * 2, tstepB = 2 * hstepB;
    const size_t hstepA = AMODE ? (size_t)64 * K * 2 : hstepB, tstepA = AMODE ? (size_t)UP_TM * K * 2 : tstepB;
    const unsigned ldsw = (unsigned)wid * 1024u;
    const int aoff = lds_byte(wr * 64 + fr, fq * 8), boff = lds_byte(wc * 32 + fr, fq * 8);
#define PG8_SA(b, h) (((b) * 2 + (h)) * HTB)
#define PG8_SB(b, h) ((4 + (b) * 2 + (h)) * HTB)
#define PG8_STAGE(bufoff, gbase, voff) do { _Pragma("unroll") for (int _i = 0; _i < 2; ++_i) \
        __builtin_amdgcn_global_load_lds((const unsigned*)((const char*)(gbase) + (voff)[_i]), (LAS unsigned*)(lds + (bufoff) + ldsw + _i * 8192), 16, 0, 0); } while (0)
#define PG8_LDA(dst, b, h) do { _Pragma("unroll") for (int m = 0; m < 4; ++m) _Pragma("unroll") for (int k = 0; k < 2; ++k) dst[m][k] = *(const LAS bf16x8*)(lds + PG8_SA(b, h) + aoff + m * 2048 + k * 1024); } while (0)
#define PG8_LDB(dst, b, h) do { _Pragma("unroll") for (int n = 0; n < 2; ++n) _Pragma("unroll") for (int k = 0; k < 2; ++k) dst[n][k] = *(const LAS bf16x8*)(lds + PG8_SB(b, h) + boff + n * 2048 + k * 1024); } while (0)
#define PG8_MMA(ai, bj, At, Bt) do { __builtin_amdgcn_s_setprio(1); _Pragma("unroll") for (int m = 0; m < 4; ++m) _Pragma("unroll") for (int n = 0; n < 2; ++n) _Pragma("unroll") for (int k = 0; k < 2; ++k) \
        acc[ai][bj][m][n] = __builtin_amdgcn_mfma_f32_16x16x32_bf16(Bt[n][k], At[m][k], acc[ai][bj][m][n], 0, 0, 0); __builtin_amdgcn_s_setprio(0); } while (0)
#define PG8_WAIT_V(n) asm volatile("s_waitcnt vmcnt(" #n ")" ::: "memory")
#define PG8_WAIT_L(n) asm volatile("s_waitcnt lgkmcnt(" #n ")" ::: "memory")
#define PG8_BAR __builtin_amdgcn_s_barrier()
#define PG8_SCHED __builtin_amdgcn_sched_barrier(0)
    Unit cur, nxt; int ui = 0;
    if (!S.next(0, cur)) return;
#define PG8_HALF(i) (SPLIT2 ? ((i) & 1) : 0)
#define PG8_NEXT(i, u) (SPLIT2 ? S.next((i) >> 1, u) : S.next((i), u))
    f32x4 acc[2][2][4][2];
#pragma unroll
    for (int a = 0; a < 2; ++a)
#pragma unroll
        for (int b = 0; b < 2; ++b)
#pragma unroll
            for (int m = 0; m < 4; ++m)
#pragma unroll
                for (int n = 0; n < 2; ++n) acc[a][b][m][n] = (f32x4){0.f, 0.f, 0.f, 0.f};
    bf16x8 At[4][2], B0[2][2], B1[2][2];
    const char* cA = (const char*)g.A + (size_t)cur.pm * tstepA; const char* cB = (const char*)g.Bt + (size_t)cur.pn * tstepB;
    PG8_STAGE(PG8_SB(0, 0), cB, voffB); PG8_STAGE(PG8_SB(0, 1), cB + hstepB, voffB); PG8_STAGE(PG8_SA(0, 0), cA, voffA); PG8_STAGE(PG8_SA(0, 1), cA + hstepA, voffA);
    if (wr == 1) PG8_BAR;
    PG8_WAIT_V(2); PG8_BAR;
    PG8_STAGE(PG8_SB(1, 0), cB + kstep, voffB); PG8_STAGE(PG8_SA(1, 0), cA + kstep, voffA); PG8_STAGE(PG8_SB(1, 1), cB + hstepB + kstep, voffB);
    PG8_WAIT_V(6); PG8_BAR;
    for (;;) {
        const bool has_next = PG8_NEXT(ui + 1, nxt);
        const char* nA = has_next ? (const char*)g.A + (size_t)nxt.pm * tstepA + PG8_HALF(ui + 1) * koff : cA; const char* nB = has_next ? (const char*)g.Bt + (size_t)nxt.pn * tstepB + PG8_HALF(ui + 1) * koff : cB;
        for (int t = 0; t < nt; t += 2) {
            const bool last = (t == nt - 2);
            const char* a1 = cA + (size_t)(t + 1) * kstep;
            const char* a2 = last ? nA : cA + (size_t)(t + 2) * kstep; const char* b2 = last ? nB : cB + (size_t)(t + 2) * kstep;
            const char* a3 = a2 + kstep; const char* b3 = b2 + kstep;
            PG8_LDB(B0, 0, 0); PG8_LDB(B1, 0, 1); PG8_SCHED; PG8_LDA(At, 0, 0); PG8_STAGE(PG8_SA(1, 1), a1 + hstepA, voffA);
            PG8_WAIT_V(8); PG8_WAIT_L(0); PG8_BAR; PG8_MMA(0, 0, At, B0); PG8_MMA(0, 1, At, B1); PG8_BAR; PG8_SCHED;
            PG8_LDA(At, 0, 1); PG8_STAGE(PG8_SB(0, 0), b2, voffB); PG8_STAGE(PG8_SB(0, 1), b2 + hstepB, voffB); PG8_STAGE(PG8_SA(0, 0), a2, voffA);
            PG8_WAIT_V(8); PG8_WAIT_L(0); PG8_BAR; PG8_MMA(1, 0, At, B0); PG8_MMA(1, 1, At, B1); PG8_BAR; PG8_SCHED;
            PG8_LDB(B0, 1, 0); PG8_LDB(B1, 1, 1); PG8_SCHED; PG8_LDA(At, 1, 0); PG8_STAGE(PG8_SA(0, 1), a2 + hstepA, voffA);
            PG8_WAIT_V(8); PG8_WAIT_L(0); PG8_BAR; PG8_MMA(0, 0, At, B0); PG8_MMA(0, 1, At, B1); PG8_BAR; PG8_SCHED;
            PG8_LDA(At, 1, 1); PG8_STAGE(PG8_SB(1, 0), b3, voffB); PG8_STAGE(PG8_SB(1, 1), b3 + hstepB, voffB); PG8_STAGE(PG8_SA(1, 0), a3, voffA);
            PG8_WAIT_V(8); PG8_WAIT_L(0); PG8_BAR; PG8_MMA(1, 0, At, B0); PG8_MMA(1, 1, At, B1); PG8_BAR; PG8_SCHED;
        }
        if (wr == 0) PG8_BAR;
        if constexpr (SPLIT2) {
            const bool fin = PG8_HALF(ui) == 1;
            if (fin) E(acc, cur, wr, wc, fr, fq);
            if (fin && !has_next) break;
            float fs[8]; E.scales(fs, cur, fin, wr, fr);
#pragma unroll
            for (int a = 0; a < 2; ++a)
#pragma unroll
                for (int b = 0; b < 2; ++b)
#pragma unroll
                    for (int m = 0; m < 4; ++m)
#pragma unroll
                        for (int n = 0; n < 2; ++n) acc[a][b][m][n] *= fs[a * 4 + m];
        } else {
        E(acc, cur, wr, wc, fr, fq);
        if (!has_next) break;
#pragma unroll
        for (int a = 0; a < 2; ++a)
#pragma unroll
            for (int b = 0; b < 2; ++b)
#pragma unroll
                for (int m = 0; m < 4; ++m)
#pragma unroll
                    for (int n = 0; n < 2; ++n) acc[a][b][m][n] = (f32x4){0.f, 0.f, 0.f, 0.f};
        }
        cur = nxt; cA = nA; cB = nB; ++ui;
        if (wr == 1) PG8_BAR;
    }
    PG8_WAIT_V(0);
    PG8_BAR;
#undef PG8_HALF
#undef PG8_NEXT
#undef PG8_SA
#undef PG8_SB
#undef PG8_STAGE
#undef PG8_LDA
#undef PG8_LDB
#undef PG8_MMA
#undef PG8_WAIT_V
#undef PG8_WAIT_L
#undef PG8_BAR
#undef PG8_SCHED
}
}
using pg8::Unit;
typedef f32x4 AccT[2][2][4][2];

struct EpiIn {
    static constexpr int MID_T = 0;
    bf16_t* qkvu; const float* ropec; const float* ropes;
    __device__ __forceinline__ void operator()(const AccT& acc, const Unit& u, int wr, int wc, int fr, int fq) const {
        const int t = u.pn >> 1;
        bf16_t* base = qkvu + (size_t)t * M * DH;
        const int col0 = (u.pn & 1) * 256 + wc * 32 + 8 * fq;
        const bool rope = (t < 2) && ((wc & 1) == 0);
#pragma unroll
        for (int ai = 0; ai < 2; ++ai)
#pragma unroll
            for (int m = 0; m < 4; ++m) {
                const int row = u.pm * 256 + ai * 128 + wr * 64 + m * 16 + fr;
                f32x4 v[2][2];
#pragma unroll
                for (int bj = 0; bj < 2; ++bj)
#pragma unroll
                    for (int n = 0; n < 2; ++n) v[bj][n] = acc[ai][bj][m][n];
                if (rope) {
                    const int pos = row_pos(row);
#pragma unroll
                    for (int n = 0; n < 2; ++n) {
                        const f32x4 c4 = *(const f32x4*)(ropec + pos * 8 + 4 * n), s4 = *(const f32x4*)(ropes + pos * 8 + 4 * n);
#pragma unroll
                        for (int bj = 0; bj < 2; ++bj) {
                            f32x4 o;
#pragma unroll
                            for (int e = 0; e < 4; ++e) o[e] = __shfl_xor(v[bj][n][e], 16);
                            const f32x4 r0 = v[bj][n] * c4 - o * s4, r1 = v[bj][n] * c4 + o * s4;
                            if (fq == 0) v[bj][n] = r0; else if (fq == 1) v[bj][n] = r1;
                        }
                    }
                }
#pragma unroll
                for (int bj = 0; bj < 2; ++bj) {
                    u32x4 w; w.x = cvt_pk_bf16(v[bj][0][0], v[bj][0][1]); w.y = cvt_pk_bf16(v[bj][0][2], v[bj][0][3]); w.z = cvt_pk_bf16(v[bj][1][0], v[bj][1][1]); w.w = cvt_pk_bf16(v[bj][1][2], v[bj][1][3]);
                    *(u32x4*)(base + (size_t)row * DH + col0 + bj * 128) = w;
                }
            }
    }
};
struct EpiGlu {
    static constexpr int MID_T = 0;
    const bf16_t* spre; bf16_t* mix; const float* bglu; float* ssq_s;
    __device__ __forceinline__ void operator()(const AccT& acc, const Unit& u, int wr, int wc, int fr, int fq) const {
        const int col0 = u.pn * 256 + wc * 32 + 8 * fq;
#pragma unroll
        for (int ai = 0; ai < 2; ++ai)
#pragma unroll
            for (int m = 0; m < 4; ++m) {
                const int row = u.pm * 256 + ai * 128 + wr * 64 + m * 16 + fr; float ss = 0.f;
#pragma unroll
                for (int bj = 0; bj < 2; ++bj) {
                    const int col = col0 + bj * 128;
                    const u32x4 sv = *(const u32x4*)(spre + (size_t)row * DH + col);
                    const f32x4 b0 = *(const f32x4*)(bglu + col), b1 = *(const f32x4*)(bglu + col + 4);
                    const f32x4 z0 = acc[ai][bj][m][0] + b0, z1 = acc[ai][bj][m][1] + b1;
                    float o[8];
                    o[0] = bf_lo(sv.x) * sigmoidf_(z0[0]); o[1] = bf_hi(sv.x) * sigmoidf_(z0[1]); o[2] = bf_lo(sv.y) * sigmoidf_(z0[2]); o[3] = bf_hi(sv.y) * sigmoidf_(z0[3]);
                    o[4] = bf_lo(sv.z) * sigmoidf_(z1[0]); o[5] = bf_hi(sv.z) * sigmoidf_(z1[1]); o[6] = bf_lo(sv.w) * sigmoidf_(z1[2]); o[7] = bf_hi(sv.w) * sigmoidf_(z1[3]);
#pragma unroll
                    for (int e = 0; e < 8; ++e) ss += o[e] * o[e];
                    u32x4 w; w.x = cvt_pk_bf16(o[0], o[1]); w.y = cvt_pk_bf16(o[2], o[3]); w.z = cvt_pk_bf16(o[4], o[5]); w.w = cvt_pk_bf16(o[6], o[7]);
                    *(u32x4*)(mix + (size_t)row * D + DH + col) = w;
                }
                ss += __shfl_xor(ss, 16); ss += __shfl_xor(ss, 32);
                if (fq == 0) atomicAdd(ssq_s + row, ss);
                asm volatile("" ::: "memory");
            }
    }
};
struct EpiOut {
    static constexpr int MID_T = 8;
    const float* xp; const float* xs; float* out; bf16_t* y1b; const float* ssq_a; const float* ssq_s; float* ln_sum; float* ln_sq;
    __device__ __forceinline__ void scales(float (&fs)[8], const Unit& u, bool fin, int wr, int fr) const {
#pragma unroll
        for (int i = 0; i < 8; ++i) {
            const int row = u.pm * 256 + (i >> 2) * 128 + wr * 64 + (i & 3) * 16 + fr;
            const float va = ssq_a[row] * (1.0f / DH) + LN_EPS, vs = ssq_s[row] * (1.0f / DH) + LN_EPS;
            const float f = __builtin_amdgcn_sqrtf(vs * fast_rcp(va));
            fs[i] = fin ? 0.f : f;
        }
    }
    __device__ __forceinline__ void operator()(const AccT& acc, const Unit& u, int wr, int wc, int fr, int fq) const {
        const int col0 = u.pn * 256 + wc * 32 + 8 * fq;
        const float* xb = (u.pm < MP / 256) ? xp : xs - (size_t)MP * D;
#pragma unroll
        for (int ai = 0; ai < 2; ++ai)
#pragma unroll
            for (int m = 0; m < 4; ++m) {
                const int row = u.pm * 256 + ai * 128 + wr * 64 + m * 16 + fr;
                const float rs = __builtin_amdgcn_rsqf(ssq_s[row] * (1.0f / DH) + LN_EPS);
                const size_t ro = (size_t)row * D + col0;
                float s1 = 0.f, s2 = 0.f;
#pragma unroll
                for (int bj = 0; bj < 2; ++bj)
#pragma unroll
                    for (int n = 0; n < 2; ++n) {
                        const size_t o = ro + bj * 128 + 4 * n;
                        const f32x4 x0 = *(const f32x4*)(xb + o);
                        const f32x4 y0 = x0 * DN_ALPHA + acc[ai][bj][m][n] * rs;
                        *(f32x4*)(out + o) = y0;
                        s1 += (y0[0] + y0[1]) + (y0[2] + y0[3]); s2 += (y0[0] * y0[0] + y0[1] * y0[1]) + (y0[2] * y0[2] + y0[3] * y0[3]);
                        *(u32x2*)(y1b + o) = (u32x2){cvt_pk_bf16(y0[0], y0[1]), cvt_pk_bf16(y0[2], y0[3])};
                    }
                s1 += __shfl_xor(s1, 16); s1 += __shfl_xor(s1, 32); s2 += __shfl_xor(s2, 16); s2 += __shfl_xor(s2, 32);
                if (fq == 0) { atomicAdd(ln_sum + row, s1); atomicAdd(ln_sq + row, s2); }
                asm volatile("" ::: "memory");
            }
    }
};
struct EpiUp {
    static constexpr int MID_T = 0;
    bf16_t* f; const float* gW; const float* bW; const float* convw; const float* convb; const float* ln_sum; const float* ln_sq;
    __device__ __forceinline__ void operator()(const AccT& acc, const Unit& u, int wr, int wc, int fr, int fq) const {
        const int feat0 = u.pn * 128 + wc * 32 + 8 * fq;
        const int pc0 = u.pn * 256 + wc * 32 + 8 * fq;
        const int rbase = u.pm * UP_TM + wr * 126 - 1;
        float ra[8], rb[8];
        unsigned vmask = 0, pmask = 0, nmask = 0;
#pragma unroll
        for (int i = 0; i < 8; ++i) {
            const int lr = (i >> 2) * 64 + (i & 3) * 16 + fr;
            const int rowu = rbase + lr; const int row = rowu < 0 ? 0 : (rowu >= M ? M - 1 : rowu);
            const float mu = ln_sum[row] * (1.0f / D), var = ln_sq[row] * (1.0f / D) - mu * mu, rstd = __builtin_amdgcn_rsqf(var + LN_EPS);
            ra[i] = rstd; rb[i] = -rstd * mu;
            const int pos = row_pos(row), sl = row_slen(row);
            if ((lr >= 1) && (lr <= 126) && (rowu >= 0) && (rowu < M)) vmask |= 1u << i;
            if (pos != 0) pmask |= 1u << i;
            if (pos != sl - 1) nmask |= 1u << i;
        }
#pragma unroll
        for (int n = 0; n < 2; ++n) {
            const f32x4 gWg = *(const f32x4*)(gW + pc0 + 4 * n), bWg = *(const f32x4*)(bW + pc0 + 4 * n), gWv = *(const f32x4*)(gW + pc0 + 128 + 4 * n), bWv = *(const f32x4*)(bW + pc0 + 128 + 4 * n);
            const f32x4 w0 = *(const f32x4*)(convw + feat0 + 4 * n), w1 = *(const f32x4*)(convw + FF + feat0 + 4 * n), w2 = *(const f32x4*)(convw + 2 * FF + feat0 + 4 * n), cb = *(const f32x4*)(convb + feat0 + 4 * n);
            f32x4 gp = (f32x4){0.f, 0.f, 0.f, 0.f};
            f32x4 gc = acc[0][0][0][n] * ra[0] + (gWg * rb[0] + bWg);
#pragma unroll
            for (int i = 0; i < 8; ++i) {
                f32x4 gn = gc;
                if (i < 7) gn = acc[(i + 1) >> 2][0][(i + 1) & 3][n] * ra[i + 1] + (gWg * rb[i + 1] + bWg);
                const f32x4 val = acc[i >> 2][1][i & 3][n] * ra[i] + (gWv * rb[i] + bWv);
                const bool hasp = (pmask >> i) & 1u, hasn = (nmask >> i) & 1u;
                f32x4 o;
#pragma unroll
                for (int e = 0; e < 4; ++e) {
                    const float selp = (fr == 15) ? gp[e] : gc[e];
                    const float seln = (fr == 0) ? gn[e] : gc[e];
                    float pv = dpp_f<0x121>(selp);
                    float nv = dpp_f<0x12F>(seln);
                    pv = hasp ? pv : 0.f; nv = hasn ? nv : 0.f;
                    const float cv = w0[e] * pv + w1[e] * gc[e] + w2[e] * nv + cb[e];
                    o[e] = gelu_tanh(cv) * val[e];
                }
                if ((vmask >> i) & 1u) {
                    const int row = rbase + (i >> 2) * 64 + (i & 3) * 16 + fr;
                    *(u32x2*)(f + (size_t)row * FF + feat0 + 4 * n) = (u32x2){cvt_pk_bf16(o[0], o[1]), cvt_pk_bf16(o[2], o[3])};
                }
                gp = gc; gc = gn;
            }
        }
    }
};
struct EpiDown {
    static constexpr int MID_T = 0;
    float* out; const float* g1; const float* b1; const float* ln1_sum; const float* ln1_sq; float* ln2_sum; float* ln2_sq;
    __device__ __forceinline__ void operator()(const AccT& acc, const Unit& u, int wr, int wc, int fr, int fq) const {
        const int col0 = u.pn * 256 + wc * 32 + 8 * fq;
#pragma unroll
        for (int ai = 0; ai < 2; ++ai)
#pragma unroll
            for (int m = 0; m < 4; ++m) {
                const int row = u.pm * 256 + ai * 128 + wr * 64 + m * 16 + fr;
                const float mu = ln1_sum[row] * (1.0f / D), var = ln1_sq[row] * (1.0f / D) - mu * mu, rstd = __builtin_amdgcn_rsqf(var + LN_EPS);
                float s1 = 0.f, s2 = 0.f;
#pragma unroll
                for (int bj = 0; bj < 2; ++bj)
#pragma unroll
                    for (int n = 0; n < 2; ++n) {
                        const int col = col0 + bj * 128 + 4 * n;
                        float* p = out + (size_t)row * D + col;
                        const f32x4 y1 = *(const f32x4*)p, gg = *(const f32x4*)(g1 + col), bb = *(const f32x4*)(b1 + col);
                        const f32x4 x1 = (y1 - mu) * rstd * gg + bb;
                        const f32x4 y2 = x1 * DN_ALPHA + acc[ai][bj][m][n];
                        *(f32x4*)p = y2;
#pragma unroll
                        for (int e = 0; e < 4; ++e) { s1 += y2[e]; s2 += y2[e] * y2[e]; }
                    }
                s1 += __shfl_xor(s1, 16); s1 += __shfl_xor(s1, 32); s2 += __shfl_xor(s2, 16); s2 += __shfl_xor(s2, 32);
                if (fq == 0) { atomicAdd(ln2_sum + row, s1); atomicAdd(ln2_sq + row, s2); }
                asm volatile("" ::: "memory");
            }
    }
};

__device__ __forceinline__ unsigned f2bf(float f) { unsigned u = __float_as_uint(f); return (u + 0x7fffu + ((u >> 16) & 1u)) >> 16; }
__device__ __forceinline__ unsigned pk2(float lo, float hi) { return f2bf(lo) | (f2bf(hi) << 16); }
template <int UPMAP>
__device__ __forceinline__ void p0_transpose_item(const float* W, int K, int N, bf16_t* WT, const float* ks, const float* ks2, LAS float* scr, int item, int lane) {
    const int nblk = N / 32, kb = item / nblk, nb = item % nblk, k0 = 64 * kb, n0 = 32 * nb;
#pragma unroll 8
    for (int i = 0; i < 32; ++i) { const int kk = 2 * i + (lane >> 5); float sc = 1.0f; if (ks) { const int kg = k0 + kk; sc = (ks2 && kg >= DH) ? ks2[kg - DH] : ks[kg]; }
        scr[kk * 33 + (lane & 31)] = W[(size_t)(k0 + kk) * N + n0 + (lane & 31)] * sc; }
    asm volatile("s_waitcnt lgkmcnt(0)" ::: "memory");
    const int c = lane & 7;
#pragma unroll
    for (int j = 0; j < 4; ++j) { const int n = (lane >> 3) + 8 * j; const LAS float* s = scr + (8 * c) * 33 + n;
        u32x4 o; o.x = pk2(s[0 * 33], s[1 * 33]); o.y = pk2(s[2 * 33], s[3 * 33]); o.z = pk2(s[4 * 33], s[5 * 33]); o.w = pk2(s[6 * 33], s[7 * 33]);
        int ng = n0 + n;
        if (UPMAP) { const int isv = ng >= FF, ft = isv ? ng - FF : ng; ng = 256 * (ft >> 7) + 128 * isv + (ft & 127); }
        *(u32x4*)(WT + (size_t)ng * K + k0 + 8 * c) = o; }
    asm volatile("s_waitcnt lgkmcnt(0)" ::: "memory");
}

__device__ __forceinline__ void p0_prep(const Params& P, LAS unsigned char* lds, int gw, int NGW, int lane) {
    unsigned char* ws = P.ws;
    const int wave = threadIdx.x >> 6;
    LAS float* scr = (LAS float*)(lds + wave * 16384);
    constexpr int I_IN = (D / 64) * (NIN / 32), I_GLU = (DH / 64) * (DH / 32), I_OUT = (D / 64) * (D / 32), I_UP = (D / 64) * (NUP / 32), I_DN = (FF / 64) * (D / 32);
    constexpr int NITEMS = I_IN + I_GLU + I_OUT + I_UP + I_DN;
    for (int it = gw; it < NITEMS; it += NGW) {
        int r = it;
        if (r < I_IN) { p0_transpose_item<0>(P.in[2], D, NIN, (bf16_t*)(ws + WS_WIN), nullptr, nullptr, scr, r, lane); continue; } r -= I_IN;
        if (r < I_GLU) { p0_transpose_item<0>(P.in[12], DH, DH, (bf16_t*)(ws + WS_WGLU), nullptr, nullptr, scr, r, lane); continue; } r -= I_GLU;
        if (r < I_OUT) { p0_transpose_item<0>(P.in[15], D, D, (bf16_t*)(ws + WS_WOUT), P.in[3], P.in[14], scr, r, lane); continue; } r -= I_OUT;
        if (r < I_UP) { p0_transpose_item<1>(P.in[18], D, NUP, (bf16_t*)(ws + WS_WUP), P.in[16], nullptr, scr, r, lane); continue; } r -= I_UP;
        p0_transpose_item<0>(P.in[21], FF, D, (bf16_t*)(ws + WS_WDN), nullptr, nullptr, scr, r, lane);
    }
    const int gt = gw * 64 + lane, NGT = NGW * 64;
    for (int n = gt; n < NUP; n += NGT) {
        const float* w = P.in[18]; const float* g = P.in[16]; const float* b = P.in[17];
        float sg = 0.f, sb = 0.f;
        for (int k = 0; k < D; ++k) { const float wv = w[(size_t)k * NUP + n]; sg += __uint_as_float(f2bf(g[k] * wv) << 16); sb += b[k] * wv; }
        const int isv = n >= FF, ft = isv ? n - FF : n, pc = 256 * (ft >> 7) + 128 * isv + (ft & 127);
        ((float*)(ws + WS_GW))[pc] = sg; ((float*)(ws + WS_BW))[pc] = sb;
    }
    for (int i = gt; i < 6 * M / 4; i += NGT) ((f32x4*)(ws + WS_STATS))[i] = (f32x4){0.f, 0.f, 0.f, 0.f};
    for (int i = gt; i < 16384 * 8; i += NGT) {
        const int pos = i >> 3, j = i & 7;
        const double invf[8] = {1.0, 0.19392274474868576, 0.03760603093086393, 0.007292664737217109, 0.001414213562373095, 0.0002742481756762073, 5.318295896944988e-05, 1.031338537721246e-05};
        double fr_ = 1.0;
#pragma unroll
        for (int q = 0; q < 8; ++q) fr_ = (j == q) ? invf[q] : fr_;
        const double ang = (double)pos * fr_;
        const double k2 = rint(ang * 0.15915494309189535);
        const double red = fma(-k2, 6.283185307179586, ang) - k2 * 2.4492935982947064e-16;
        float sn, cs; sincosf((float)red, &sn, &cs);
        ((float*)(ws + WS_ROPEC))[i] = cs; ((float*)(ws + WS_ROPES))[i] = sn;
    }
    for (int i = gt; i < 2 * 32 * 64; i += NGT) {
        const int dg = i >> 6;
        const double dt = exp((double)P.in[6][dg]);
        const double are = P.in[4][i], aim = P.in[5][i];
        const double mag = exp(are * dt), ang = aim * dt;
        double lr = mag * cos(ang), li = mag * sin(ang);
        ((f32x2*)(ws + WS_LAM))[i] = (f32x2){(float)lr, (float)li};
        for (int q = 0; q < 6; ++q) { const double t = lr * lr - li * li; li = 2.0 * lr * li; lr = t; }
        ((f32x2*)(ws + WS_LAML))[i] = (f32x2){(float)lr, (float)li};
    }
    for (int i = gt; i < 2 * 32 * 8 * 64; i += NGT) {
        const int ln = i & 63, T = (i >> 6) & 7, dg = i >> 9;
        const int s = T >> 1, ri = T & 1, p = 16 * s + (ln & 15);
        const double dt = exp((double)P.in[6][dg]);
        const double are = P.in[4][dg * 64 + p], aim = P.in[5][dg * 64 + p];
        const double mag = exp(are * dt), ang = aim * dt;
        const double lr = mag * cos(ang) - 1.0, li = mag * sin(ang);
        const double den = are * are + aim * aim;
        const double cr = (lr * are + li * aim) / den, ci = (li * are - lr * aim) / den;
        unsigned short v[4];
#pragma unroll
        for (int j = 0; j < 4; ++j) { const int c = 4 * (ln >> 4) + j; const size_t bi = ((size_t)dg * 64 + p) * 16 + c;
            const double br = P.in[7][bi], bim = P.in[8][bi];
            const double o = ri == 0 ? (cr * br - ci * bim) : (cr * bim + ci * br);
            v[j] = (unsigned short)f2bf((float)o); }
        ((u32x2*)(ws + WS_BFRAG))[i] = (u32x2){(unsigned)v[0] | ((unsigned)v[1] << 16), (unsigned)v[2] | ((unsigned)v[3] << 16)};
    }
    for (int i = gt; i < 32 * 4 * 64; i += NGT) {
        const int ln = i & 63, kb = (i >> 6) & 3, g = i >> 8;
        const int ch = ln & 15, q = ln >> 4;
        unsigned short v[8];
#pragma unroll
        for (int jj = 0; jj < 8; ++jj) { const int p = 16 * kb + 4 * q + (jj & 3); const size_t ci = ((size_t)g * 16 + ch) * 64 + p;
            v[jj] = (unsigned short)f2bf(jj < 4 ? P.in[9][ci] : -P.in[10][ci]); }
        ((u32x4*)(ws + WS_CFRAG))[i] = (u32x4){(unsigned)v[0] | ((unsigned)v[1] << 16), (unsigned)v[2] | ((unsigned)v[3] << 16), (unsigned)v[4] | ((unsigned)v[5] << 16), (unsigned)v[6] | ((unsigned)v[7] << 16)};
    }
    for (size_t i = gt; i < (size_t)M * D / 8; i += NGT) {
        const size_t e = i * 8; const float* src = e < (size_t)MP * D ? P.in[0] + e : P.in[1] + (e - (size_t)MP * D);
        const f32x4 a = *(const f32x4*)src, b = *(const f32x4*)(src + 4);
        u32x4 w; w.x = cvt_pk_bf16(a[0], a[1]); w.y = cvt_pk_bf16(a[2], a[3]); w.z = cvt_pk_bf16(b[0], b[1]); w.w = cvt_pk_bf16(b[2], b[3]);
        ((u32x4*)(ws + WS_XB))[i] = w;
    }
}

constexpr int VROW = 144;
__device__ __forceinline__ void attn_tile(const bf16_t* __restrict__ Q, const bf16_t* __restrict__ Kt, const bf16_t* __restrict__ Vt, bf16_t* mix, float* ssq_a,
                                          LAS unsigned char* vl, int rb, int h, int r, int lane) {
    const int row0 = rb * 256;
    const int S = row_slen(row0), sbrow = row0 - row_pos(row0);
    const int i0 = row_pos(row0) >> 4;
    const int qi = lane & 15, g4 = lane >> 4;
    const int tq = r + 16 * (i0 + qi);
    bf16x8 qf[2];
#pragma unroll
    for (int kk = 0; kk < 2; ++kk) qf[kk] = *(const bf16x8*)(Q + (size_t)(sbrow + tq) * DH + h * 64 + 32 * kk + 8 * g4);
    f32x4 O[4];
#pragma unroll
    for (int db = 0; db < 4; ++db) O[db] = (f32x4){0.f, 0.f, 0.f, 0.f};
    float mrun = -1e30f, lsum = 0.f;
    const float SC = 0.125f * 1.4426950408889634f;
    const unsigned vrd = (unsigned)((4 * g4 + ((lane & 15) >> 2)) * VROW + (lane & 3) * 8);
#pragma unroll 1
    for (int br = 0; br < 3; ++br) {
        const int dil = br == 0 ? 16 : (br == 1 ? 4 : 1);
        const int nstep = br == 0 ? 5 : (br == 1 ? 6 : 12);
        const int qpos = (16 / dil) * (i0 + qi);
        const int mlo = (16 / dil) * i0 - 64;
#pragma unroll 1
        for (int st = 0; st < nstep; ++st) {
            const int mb = mlo + 32 * st;
            bf16x8 kf[2][2];
#pragma unroll
            for (int blk = 0; blk < 2; ++blk) {
                int tok = r + dil * (mb + 16 * blk + qi); tok = tok < 0 ? 0 : (tok >= S ? S - 1 : tok);
                const bf16_t* kp = Kt + (size_t)(sbrow + tok) * DH + h * 64 + 8 * g4;
                kf[blk][0] = *(const bf16x8*)kp; kf[blk][1] = *(const bf16x8*)(kp + 32);
            }
            u32x4 vreg[4];
#pragma unroll
            for (int i = 0; i < 4; ++i) { const int idx = lane + 64 * i, rw = idx >> 3, ch = idx & 7;
                int tok = r + dil * (mb + rw); tok = tok < 0 ? 0 : (tok >= S ? S - 1 : tok);
                vreg[i] = *(const u32x4*)(Vt + (size_t)(sbrow + tok) * DH + h * 64 + 8 * ch); }
            f32x4 sa[2];
#pragma unroll
            for (int blk = 0; blk < 2; ++blk) {
                sa[blk] = __builtin_amdgcn_mfma_f32_16x16x32_bf16(kf[blk][0], qf[0], (f32x4){0.f, 0.f, 0.f, 0.f}, 0, 0, 0);
                sa[blk] = __builtin_amdgcn_mfma_f32_16x16x32_bf16(kf[blk][1], qf[1], sa[blk], 0, 0, 0);
            }
#pragma unroll
            for (int i = 0; i < 4; ++i) { const int idx = lane + 64 * i, rw = idx >> 3, ch = idx & 7; *(LAS u32x4*)(vl + rw * VROW + ch * 16) = vreg[i]; }
            float sv[8]; float mx = -INFINITY;
#pragma unroll
            for (int blk = 0; blk < 2; ++blk)
#pragma unroll
                for (int j = 0; j < 4; ++j) {
                    const int mk = mb + 16 * blk + 4 * g4 + j, tk = r + dil * mk, dd = mk - qpos;
                    const bool ok = (tk >= 0) && (tk < S) && (dd >= -64) && (dd <= 64);
                    const float s = ok ? sa[blk][j] * SC : -INFINITY;
                    sv[blk * 4 + j] = s; mx = fmaxf(mx, s);
                }
            mx = fmaxf(mx, __shfl_xor(mx, 16)); mx = fmaxf(mx, __shfl_xor(mx, 32));
            const float mnew = fmaxf(mrun, mx), alpha = fast_exp2(mrun - mnew);
            mrun = mnew;
            float p[8]; float ps = 0.f;
#pragma unroll
            for (int e = 0; e < 8; ++e) { p[e] = fast_exp2(sv[e] - mnew); ps += p[e]; }
            lsum = lsum * alpha + ps;
#pragma unroll
            for (int db = 0; db < 4; ++db) O[db] *= alpha;
            bf16x8 pf;
            { const unsigned w0 = cvt_pk_bf16(p[0], p[1]), w1 = cvt_pk_bf16(p[2], p[3]), w2 = cvt_pk_bf16(p[4], p[5]), w3 = cvt_pk_bf16(p[6], p[7]);
              const u32x4 w = (u32x4){w0, w1, w2, w3}; pf = __builtin_bit_cast(bf16x8, w); }
#pragma unroll
            for (int db = 0; db < 4; ++db) {
                typedef short v4i16_t __attribute__((ext_vector_type(4)));
                const v4i16_t lo = __builtin_amdgcn_ds_read_tr16_b64_v4i16((LAS v4i16_t*)(vl + vrd + db * 32));
                const v4i16_t hi = __builtin_amdgcn_ds_read_tr16_b64_v4i16((LAS v4i16_t*)(vl + vrd + 16 * VROW + db * 32));
                const bf16x8 vf = (bf16x8){lo[0], lo[1], lo[2], lo[3], hi[0], hi[1], hi[2], hi[3]};
                O[db] = __builtin_amdgcn_mfma_f32_16x16x32_bf16(vf, pf, O[db], 0, 0, 0);
            }
        }
    }
    lsum += __shfl_xor(lsum, 16); lsum += __shfl_xor(lsum, 32);
    const float inv = 1.0f / lsum;
    float ss = 0.f;
    bf16_t* orow = mix + (size_t)(sbrow + tq) * D + h * 64 + 4 * g4;
#pragma unroll
    for (int db = 0; db < 4; ++db) {
        const f32x4 o = O[db] * inv;
        ss += o[0] * o[0] + o[1] * o[1] + o[2] * o[2] + o[3] * o[3];
        *(u32x2*)(orow + 16 * db) = (u32x2){cvt_pk_bf16(o[0], o[1]), cvt_pk_bf16(o[2], o[3])};
    }
    ss += __shfl_xor(ss, 16); ss += __shfl_xor(ss, 32);
    if (g4 == 0) atomicAdd(ssq_a + sbrow + tq, ss);
}

template <int MODE>
__device__ __forceinline__ void ssm_task(const Params& P, int sbk, int g, int dir, int lane) {
    unsigned char* ws = P.ws;
    const int c = lane & 15, q = lane >> 4, dg = dir * 32 + g;
    const bf16_t* U = (const bf16_t*)(ws + WS_U);
    f32x2* ST = (f32x2*)(ws + WS_ST);
    bf16x4 bfr[8];
#pragma unroll
    for (int T = 0; T < 8; ++T) bfr[T] = __builtin_bit_cast(bf16x4, ((const u32x2*)(ws + WS_BFRAG))[(dg * 8 + T) * 64 + lane]);
    f32x2 lam[4][4], h[4][4];
#pragma unroll
    for (int s = 0; s < 4; ++s)
#pragma unroll
        for (int j = 0; j < 4; ++j) { lam[s][j] = ((const f32x2*)(ws + WS_LAM))[dg * 64 + 16 * s + 4 * q + j]; h[s][j] = (f32x2){0.f, 0.f}; }
    const int chunk = sbk * 16 + c;
    const size_t stbase = ((size_t)dg * NCHUNK + chunk) * 64;
    if (MODE != 0) {
#pragma unroll
        for (int s = 0; s < 4; ++s)
#pragma unroll
            for (int j = 0; j < 4; ++j) h[s][j] = ST[stbase + 16 * s + 4 * q + j];
    }
    bf16x8 cfr[4];
    if (MODE != 0) {
#pragma unroll
        for (int kb = 0; kb < 4; ++kb) cfr[kb] = __builtin_bit_cast(bf16x8, ((const u32x4*)(ws + WS_CFRAG))[(g * 4 + kb) * 64 + lane]);
    }
    const int tok0 = chunk * 64;
    const float dsk = P.in[11][g * 16 + c];
    u32x2 unext = *(const u32x2*)(U + (size_t)(tok0 + (dir ? 63 : 0)) * DH + g * 16 + 4 * q);
#pragma unroll 1
    for (int t = 0; t < 64; ++t) {
        const bf16x4 ub = __builtin_bit_cast(bf16x4, unext);
        if (t < 63) { const int tn = dir ? 62 - t : t + 1; unext = *(const u32x2*)(U + (size_t)(tok0 + tn) * DH + g * 16 + 4 * q); }
        f32x4 bu[8];
#pragma unroll
        for (int T = 0; T < 8; ++T) bu[T] = __builtin_amdgcn_mfma_f32_16x16x16bf16_1k(bfr[T], ub, (f32x4){0.f, 0.f, 0.f, 0.f}, 0, 0, 0);
#pragma unroll
        for (int s = 0; s < 4; ++s)
#pragma unroll
            for (int j = 0; j < 4; ++j) {
                const float hr = h[s][j].x, hi = h[s][j].y;
                h[s][j].x = lam[s][j].x * hr - lam[s][j].y * hi + bu[2 * s][j];
                h[s][j].y = lam[s][j].x * hi + lam[s][j].y * hr + bu[2 * s + 1][j];
            }
        if (MODE != 0) {
            f32x4 y = (f32x4){0.f, 0.f, 0.f, 0.f};
#pragma unroll
            for (int kb = 0; kb < 4; ++kb) {
                const u32x4 w = (u32x4){cvt_pk_bf16(h[kb][0].x, h[kb][1].x), cvt_pk_bf16(h[kb][2].x, h[kb][3].x), cvt_pk_bf16(h[kb][0].y, h[kb][1].y), cvt_pk_bf16(h[kb][2].y, h[kb][3].y)};
                y = __builtin_amdgcn_mfma_f32_16x16x32_bf16(__builtin_bit_cast(bf16x8, w), cfr[kb], y, 0, 0, 0);
            }
            const int tt = dir ? 63 - t : t;
#pragma unroll
            for (int j = 0; j < 4; ++j) {
                const size_t tok = (size_t)(sbk * 16 + 4 * q + j) * 64 + tt;
                const size_t oi = tok * DH + g * 16 + c;
                if (MODE == 1) ((float*)(ws + WS_YF))[oi] = y[j];
                else {
                    const float uu = __uint_as_float(((unsigned)U[oi]) << 16);
                    const float v = y[j] + ((const float*)(ws + WS_YF))[oi] + dsk * uu;
                    ((bf16_t*)(ws + WS_SPRE))[oi] = (bf16_t)(cvt_pk_bf16(gelu_tanh(v), 0.f) & 0xffffu);
                }
            }
        }
    }
    if (MODE == 0) {
#pragma unroll
        for (int s = 0; s < 4; ++s)
#pragma unroll
            for (int j = 0; j < 4; ++j) ST[stbase + 16 * s + 4 * q + j] = h[s][j];
    }
}
__device__ __forceinline__ void ssm_carry(const Params& P, int gt, int NGT) {
    unsigned char* ws = P.ws; f32x2* ST = (f32x2*)(ws + WS_ST);
    for (int i = gt; i < 64 * 10 * 64; i += NGT) {
        const int p = i & 63, sq = (i >> 6) % 10, dg = i / 640, dir = dg >> 5;
        const int c0 = sq < 2 ? sq * 256 : 512 + (sq - 2) * 128, nc = sq < 2 ? 256 : 128;
        const f32x2 L = ((const f32x2*)(ws + WS_LAML))[dg * 64 + p];
        f32x2 carry = (f32x2){0.f, 0.f};
        f32x2* base = ST + ((size_t)dg * NCHUNK + c0) * 64 + p;
        for (int k0 = 0; k0 < nc; k0 += 8) {
            f32x2 e[8];
#pragma unroll
            for (int k = 0; k < 8; ++k) { const int ck = dir ? nc - 1 - (k0 + k) : k0 + k; e[k] = base[(size_t)ck * 64]; }
#pragma unroll
            for (int k = 0; k < 8; ++k) { const int ck = dir ? nc - 1 - (k0 + k) : k0 + k; base[(size_t)ck * 64] = carry;
                const float cr = L.x * carry.x - L.y * carry.y + e[k].x, ci = L.x * carry.y + L.y * carry.x + e[k].y; carry = (f32x2){cr, ci}; }
        }
    }
}

constexpr int LDS_BYTES = 147456;
__global__ void __launch_bounds__(512, 2) mega_fwd(Params P, int ph_lo, int ph_hi) {
    extern __shared__ __attribute__((aligned(16))) unsigned char lds_raw[];
    LAS unsigned char* lds = (LAS unsigned char*)lds_raw;
    cg::grid_group grid = cg::this_grid();
    const int tid = threadIdx.x, lane = tid & 63, wave = __builtin_amdgcn_readfirstlane(tid >> 6);
    const int G = gridDim.x, bx = blockIdx.x;
    const int gw = bx * 8 + wave, NGW = G * 8;
    unsigned char* ws = P.ws;
    float* stats = (float*)(ws + WS_STATS);
    float* ssq_a = stats, *ssq_s = stats + M, *ln1_sum = stats + 2 * M, *ln1_sq = stats + 3 * M, *ln2_sum = stats + 4 * M, *ln2_sq = stats + 5 * M;
#ifndef PH_MASK
#define PH_MASK 0x7ff
#endif
#define IN(k) (((PH_MASK >> (k)) & 1) && ph_lo <= (k) && (k) < ph_hi)
#define SEAM(k) do { if (ph_lo <= (k) && (k) + 1 < ph_hi) grid.sync(); } while (0)
    if (IN(0)) p0_prep(P, lds, gw, NGW, lane);
    SEAM(0);
    if (IN(1)) {
        pg8::Gemm g{(const bf16_t*)(ws + WS_XB), (const bf16_t*)(ws + WS_WIN), D}; pg8::StaticOrder S; S.init(M / 256, NIN / 256, G, bx);
        EpiIn E{(bf16_t*)(ws + WS_Q), (const float*)(ws + WS_ROPEC), (const float*)(ws + WS_ROPES)};
        pg8::gemm_phase<EpiIn, 0>(lds, g, S, E);
    }
    SEAM(1);
    if (IN(2)) {
        for (int it = bx; it < (M / 256) * 8; it += G) {
            const int rb = it >> 3, h = it & 7;
            for (int r = wave; r < 16; r += 8)
                attn_tile((const bf16_t*)(ws + WS_Q), (const bf16_t*)(ws + WS_K), (const bf16_t*)(ws + WS_V), (bf16_t*)(ws + WS_MIX), ssq_a, lds + wave * 8192, rb, h, r, lane);
        }
        for (int it = gw; it < 96 * 64; it += NGW) ssm_task<0>(P, it >> 6, it & 31, (it >> 5) & 1, lane);
    }
    SEAM(2);
    if (IN(3)) ssm_carry(P, gw * 64 + lane, NGW * 64);
    SEAM(3);
    if (IN(4)) { for (int it = gw; it < 96 * 32; it += NGW) ssm_task<1>(P, it >> 5, it & 31, 0, lane); }
    SEAM(4);
    if (IN(5)) { for (int it = gw; it < 96 * 32; it += NGW) ssm_task<2>(P, it >> 5, it & 31, 1, lane); }
    SEAM(5);
    if (IN(6)) {
        pg8::Gemm g{(const bf16_t*)(ws + WS_SPRE), (const bf16_t*)(ws + WS_WGLU), DH}; pg8::StaticOrder S; S.init(M / 256, DH / 256, G, bx);
        EpiGlu E{(const bf16_t*)(ws + WS_SPRE), (bf16_t*)(ws + WS_MIX), P.in[13], ssq_s};
        pg8::gemm_phase<EpiGlu, 0>(lds, g, S, E);
    }
    SEAM(6);
    if (IN(7)) {
        pg8::Gemm g{(const bf16_t*)(ws + WS_MIX), (const bf16_t*)(ws + WS_WOUT), D}; pg8::StaticOrder S; S.init(M / 256, D / 256, G, bx);
        EpiOut E{P.in[0], P.in[1], P.out, (bf16_t*)(ws + WS_Y1B), ssq_a, ssq_s, ln1_sum, ln1_sq};
        pg8::gemm_phase<EpiOut, 0>(lds, g, S, E);
    }
    SEAM(7);
    if (IN(8)) {
        pg8::Gemm g{(const bf16_t*)(ws + WS_Y1B) - D, (const bf16_t*)(ws + WS_WUP), D}; pg8::StaticOrder S; S.init(UP_NM, NUP / 256, G, bx);
        EpiUp E{(bf16_t*)(ws + WS_F), (const float*)(ws + WS_GW), (const float*)(ws + WS_BW), P.in[19], P.in[20], ln1_sum, ln1_sq};
        pg8::gemm_phase<EpiUp, 1>(lds, g, S, E);
    }
    SEAM(8);
    if (IN(9)) {
        pg8::Gemm g{(const bf16_t*)(ws + WS_F), (const bf16_t*)(ws + WS_WDN), FF}; pg8::StaticOrder S; S.init(M / 256, D / 256, G, bx);
        EpiDown E{P.out, P.in[16], P.in[17], ln1_sum, ln1_sq, ln2_sum, ln2_sq};
        pg8::gemm_phase<EpiDown, 0>(lds, g, S, E);
    }
    SEAM(9);
    if (IN(10)) {
        const float* g2 = P.in[22]; const float* b2 = P.in[23];
        for (int row = gw; row < M; row += NGW) {
            const float mu = ln2_sum[row] * (1.0f / D), var = ln2_sq[row] * (1.0f / D) - mu * mu, rstd = __builtin_amdgcn_rsqf(var + LN_EPS);
            f32x4* p = (f32x4*)(P.out + (size_t)row * D) + lane;
#pragma unroll
            for (int j = 0; j < 4; ++j) { const f32x4 y = p[64 * j], gg = ((const f32x4*)g2)[64 * j + lane], bb = ((const f32x4*)b2)[64 * j + lane]; p[64 * j] = (y - mu) * rstd * gg + bb; }
        }
    }
#undef IN
#undef SEAM
}

extern "C" void kernel_launch(void* const* d_in, const int* in_sizes, int n_in, void* d_out, int out_size, void* d_ws, size_t ws_size, hipStream_t stream) {
    static int grid = 0;
    if (grid == 0) {
        if (n_in != 24 || ws_size < WS_END) { fprintf(stderr, "kernel_launch: unexpected n_in %d / ws_size %zu (need %zu)\n", n_in, ws_size, (size_t)WS_END); grid = -1; return; }
        int dev = 0, cus = 0, per_cu = 0;
        hipGetDevice(&dev); hipDeviceGetAttribute(&cus, hipDeviceAttributeMultiprocessorCount, dev);
        hipFuncSetAttribute((const void*)mega_fwd, hipFuncAttributeMaxDynamicSharedMemorySize, LDS_BYTES);
        hipOccupancyMaxActiveBlocksPerMultiprocessor(&per_cu, (const void*)mega_fwd, 512, LDS_BYTES);
        (void)hipGetLastError();
        if (per_cu < 1) per_cu = 1;
        grid = cus * per_cu;
    }
    if (grid < 0) return;
    Params p{};
    for (int i = 0; i < 24; ++i) p.in[i] = (const float*)d_in[i];
    p.out = (float*)d_out; p.ws = (unsigned char*)d_ws;
    int lo = 0, hi = 11;
    void* args[] = {&p, &lo, &hi};
    hipError_t e = hipLaunchCooperativeKernel((const void*)mega_fwd, dim3(grid), dim3(512), args, LDS_BYTES, stream);
    if (e != hipSuccess) fprintf(stderr, "cooperative launch failed: %s (grid %d)\n", hipGetErrorString(e), grid);
}
```

```cpp
#include <hip/hip_runtime.h>
#include <hip/hip_cooperative_groups.h>
#include <cstdio>
#include <cstdint>
namespace cg = cooperative_groups;

#define LAS __attribute__((address_space(3)))
typedef unsigned short bf16_t;
typedef short bf16x8 __attribute__((ext_vector_type(8)));
typedef short bf16x4 __attribute__((ext_vector_type(4)));
typedef float f32x4 __attribute__((ext_vector_type(4)));
typedef float f32x2 __attribute__((ext_vector_type(2)));
typedef unsigned u32x4 __attribute__((ext_vector_type(4)));
typedef unsigned u32x2 __attribute__((ext_vector_type(2)));

constexpr int M = 98304, D = 1024, NIN = 2048, DH = 512, FF = 2816, NUP = 5632;
constexpr int MP = 32768;
constexpr int CL = 32;
constexpr int NCHUNK = M / CL;
constexpr float LN_EPS = 1e-5f;
constexpr float DN_ALPHA = 1.189207115002721f;
constexpr int UP_TM = 252;
constexpr int UP_NM = (M + UP_TM - 1) / UP_TM;

constexpr size_t MiB = 1u << 20;
constexpr size_t WS_STATS = 0;
constexpr size_t WS_ROPEC = 3 * MiB, WS_ROPES = WS_ROPEC + 16384 * 8 * 4;
constexpr size_t WS_LAM = 4 * MiB + 0;
constexpr size_t WS_LAML = WS_LAM + 32768;
constexpr size_t WS_BFRAG = WS_LAML + 32768;
constexpr size_t WS_CFRAG = WS_BFRAG + 524288;
constexpr size_t WS_GW = WS_CFRAG + 163840;
constexpr size_t WS_BW = WS_GW + 32768;
static_assert(WS_BW + 32768 <= 5 * MiB, "tables");
constexpr size_t WS_WIN = 5 * MiB;
constexpr size_t WS_WGLU = 9 * MiB;
constexpr size_t WS_WOUT = 10 * MiB;
constexpr size_t WS_WUP = 12 * MiB;
constexpr size_t WS_WDN = 24 * MiB;
constexpr size_t WS_A = 32 * MiB;
constexpr size_t WS_XB = WS_A, WS_Q = WS_A + 192 * MiB, WS_K = WS_Q + 96 * MiB, WS_V = WS_K + 96 * MiB, WS_U = WS_V + 96 * MiB;
constexpr size_t WS_YF = WS_XB;
constexpr size_t WS_SPRE = WS_Q;
constexpr size_t WS_F = WS_A;
constexpr size_t WS_MIX = WS_A + 576 * MiB;
constexpr size_t WS_Y1B = WS_MIX + 192 * MiB + 1 * MiB;
constexpr size_t WS_ST = WS_Y1B;
constexpr size_t WS_END = WS_Y1B + 192 * MiB + 1 * MiB;
static_assert(WS_END <= 1024 * MiB, "workspace map must fit 1 GiB");

__device__ __forceinline__ unsigned cvt_pk_bf16(float lo, float hi) { unsigned r; asm volatile("v_cvt_pk_bf16_f32 %0, %1, %2" : "=v"(r) : "v"(lo), "v"(hi)); return r; }
__device__ __forceinline__ float bf_lo(unsigned w) { return __uint_as_float(w << 16); }
__device__ __forceinline__ float bf_hi(unsigned w) { return __uint_as_float(w & 0xffff0000u); }
__device__ __forceinline__ float fast_exp2(float x) { return __builtin_amdgcn_exp2f(x); }
__device__ __forceinline__ float fast_rcp(float x) { return __builtin_amdgcn_rcpf(x); }
__device__ __forceinline__ float gelu_tanh(float x) {
    const float u = x * (1.0f + 0.044715f * x * x);
    const float e = fast_exp2(u * (-2.0f * 0.7978845608028654f * 1.4426950408889634f));
    return x * fast_rcp(1.0f + e);
}
__device__ __forceinline__ float sigmoidf_(float z) { return fast_rcp(1.0f + fast_exp2(-1.4426950408889634f * z)); }
__device__ __forceinline__ int row_pos(int row) { return row < MP ? (row & 16383) : (row & 8191); }
__device__ __forceinline__ int row_slen(int row) { return row < MP ? 16384 : 8192; }
template <int CTRL> __device__ __forceinline__ float dpp_f(float v) { return __int_as_float(__builtin_amdgcn_update_dpp(0, __float_as_int(v), CTRL, 0xF, 0xF, false)); }

struct Params {
    const float* in[24];
    float* out;
    unsigned char* ws;
};

namespace pg8 {
constexpr int BM = 256, BK = 64, HALF = 128, HTB = HALF * BK * 2, STAGE_BYTES = 8 * HTB, NXCD = 8, WGM = 8;
__device__ __forceinline__ int lds_byte(int r, int c) { const int st = (r >> 4) * 2 + (c >> 5), rr = r & 15, cc = c & 31, ob = rr * 64 + cc * 2; return st * 1024 + (ob ^ (((ob >> 9) & 1) << 5)); }
__device__ __forceinline__ void stage_rc(int b, int& R, int& C) { const int st = b / 1024, sb = b % 1024, swz = sb ^ (((sb >> 9) & 1) << 5); R = (st >> 1) * 16 + swz / 64; C = (st & 1) * 32 + (swz % 64) / 2; }
__device__ __forceinline__ int perm32(int rho) { const int n = rho >> 4, i = rho & 15; return 8 * (i >> 2) + 4 * n + (i & 3); }
struct Unit { int pm, pn; };
struct Gemm { const bf16_t* A; const bf16_t* Bt; int K; };
struct StaticOrder {
    int nM, nN, nwg, G, c;
    __device__ void init(int nM_, int nN_, int G_, int c_) { nM = nM_; nN = nN_; nwg = nM * nN; G = G_; c = c_; }
    __device__ bool next(int i, Unit& u) const {
        const long L = (long)i * G + c; if (L >= nwg) return false;
        int wgid = (int)L; { const int q = nwg / NXCD, r = nwg % NXCD, xcd = wgid % NXCD, off = wgid / NXCD; wgid = (xcd < r ? xcd * (q + 1) : r * (q + 1) + (xcd - r) * q) + off; }
        const int nig = WGM * nN, gid = wgid / nig, fm = gid * WGM, gsz = (nM - fm) < WGM ? (nM - fm) : WGM;
        u.pm = fm + ((wgid % nig) % gsz); u.pn = (wgid % nig) / gsz; return true;
    }
};

template <class Epi, int AMODE>
__device__ __forceinline__ void gemm_phase(LAS unsigned char* lds, const Gemm g, const StaticOrder& S, const Epi& E) {
    const int tid = threadIdx.x, wid = __builtin_amdgcn_readfirstlane(tid >> 6), lane = tid & 63, wr = wid >> 2, wc = wid & 3, fr = lane & 15, fq = lane >> 4;
    constexpr bool SPLIT2 = Epi::MID_T > 0;
    const int K = g.K, nt = SPLIT2 ? K / BK / 2 : K / BK;
    const size_t koff = (size_t)K;
    unsigned voffA[2], voffB[2];
#pragma unroll
    for (int i = 0; i < 2; ++i) { int R, C; stage_rc(tid * 16 + i * 8192, R, C); const int Rb = (R & ~31) + perm32(R & 31);
        const int Ra = AMODE ? (126 * (R >> 6) + (R & 63)) : R;
        voffA[i] = (unsigned)(Ra * K + C) * 2u; voffB[i] = (unsigned)(Rb * K + C) * 2u; }
    const size_t kstep = (size_t)(BK * 2);
    const size_t hstepB = (size_t)HALF * K * 2, tstepB = 2 * hstepB;
    const size_t hstepA = AMODE ? (size_t)64 * K * 2 : hstepB, tstepA = AMODE ? (size_t)UP_TM * K * 2 : tstepB;
    const unsigned ldsw = (unsigned)wid * 1024u;
    const int aoff = lds_byte(wr * 64 + fr, fq * 8), boff = lds_byte(wc * 32 + fr, fq * 8);
#define PG8_SA(b, h) (((b) * 2 + (h)) * HTB)
#define PG8_SB(b, h) ((4 + (b) * 2 + (h)) * HTB)
#define PG8_STAGE(bufoff, gbase, voff) do { _Pragma("unroll") for (int _i = 0; _i < 2; ++_i) \
        __builtin_amdgcn_global_load_lds((const unsigned*)((const char*)(gbase) + (voff)[_i]), (LAS unsigned*)(lds + (bufoff) + ldsw + _i * 8192), 16, 0, 0); } while (0)
#define PG8_LDA(dst, b, h) do { _Pragma("unroll") for (int m = 0; m < 4; ++m) _Pragma("unroll") for (int k = 0; k < 2; ++k) dst[m][k] = *(const LAS bf16x8*)(lds + PG8_SA(b, h) + aoff + m * 2048 + k * 1024); } while (0)
#define PG8_LDB(dst, b, h) do { _Pragma("unroll") for (int n = 0; n < 2; ++n) _Pragma("unroll") for (int k = 0; k < 2; ++k) dst[n][k] = *(const LAS bf16x8*)(lds + PG8_SB(b, h) + boff + n * 2048 + k * 1024); } while (0)
#define PG8_MMA(ai, bj, At, Bt) do { __builtin_amdgcn_s_setprio(1); _Pragma("unroll") for (int m = 0; m < 4; ++m) _Pragma("unroll") for (int n = 0; n < 2; ++n) _Pragma("unroll") for (int k = 0; k < 2; ++k) \
        acc[ai][bj][m][n] = __builtin_amdgcn_mfma_f32_16x16x32_bf16(Bt[n][k], At[m][k], acc[ai][bj][m][n], 0, 0, 0); __builtin_amdgcn_s_setprio(0); } while (0)
#define PG8_WAIT_V(n) asm volatile("s_waitcnt vmcnt(" #n ")" ::: "memory")
#define PG8_WAIT_L(n) asm volatile("s_waitcnt lgkmcnt(" #n ")" ::: "memory")
#define PG8_BAR __builtin_amdgcn_s_barrier()
#define PG8_SCHED __builtin_amdgcn_sched_barrier(0)
    Unit cur, nxt; int ui = 0;
    if (!S.next(0, cur)) return;
#define PG8_HALF(i) (SPLIT2 ? ((i) & 1) : 0)
#define PG8_NEXT(i, u) (SPLIT2 ? S.next((i) >> 1, u) : S.next((i), u))
    f32x4 acc[2][2][4][2];
#pragma unroll
    for (int a = 0; a < 2; ++a)
#pragma unroll
        for (int b = 0; b < 2; ++b)
#pragma unroll
            for (int m = 0; m < 4; ++m)
#pragma unroll
                for (int n = 0; n < 2; ++n) acc[a][b][m][n] = (f32x4){0.f, 0.f, 0.f, 0.f};
    bf16x8 At[4][2], B0[2][2], B1[2][2];
    const char* cA = (const char*)g.A + (size_t)cur.pm * tstepA; const char* cB = (const char*)g.Bt + (size_t)cur.pn * tstepB;
    PG8_STAGE(PG8_SB(0, 0), cB, voffB); PG8_STAGE(PG8_SB(0, 1), cB + hstepB, voffB); PG8_STAGE(PG8_SA(0, 0), cA, voffA); PG8_STAGE(PG8_SA(0, 1), cA + hstepA, voffA);
    if (wr == 1) PG8_BAR;
    PG8_WAIT_V(2); PG8_BAR;
    PG8_STAGE(PG8_SB(1, 0), cB + kstep, voffB); PG8_STAGE(PG8_SA(1, 0), cA + kstep, voffA); PG8_STAGE(PG8_SB(1, 1), cB + hstepB + kstep, voffB);
    PG8_WAIT_V(6); PG8_BAR;
    for (;;) {
        const bool has_next = PG8_NEXT(ui + 1, nxt);
        const char* nA = has_next ? (const char*)g.A + (size_t)nxt.pm * tstepA + PG8_HALF(ui + 1) * koff : cA; const char* nB = has_next ? (const char*)g.Bt + (size_t)nxt.pn * tstepB + PG8_HALF(ui + 1) * koff : cB;
        for (int t = 0; t < nt; t += 2) {
            const bool last = (t == nt - 2);
            const char* a1 = cA + (size_t)(t + 1) * kstep;
            const char* a2 = last ? nA : cA + (size_t)(t + 2) * kstep; const char* b2 = last ? nB : cB + (size_t)(t + 2) * kstep;
            const char* a3 = a2 + kstep; const char* b3 = b2 + kstep;
            PG8_LDB(B0, 0, 0); PG8_LDB(B1, 0, 1); PG8_SCHED; PG8_LDA(At, 0, 0); PG8_STAGE(PG8_SA(1, 1), a1 + hstepA, voffA);
            PG8_WAIT_V(8); PG8_WAIT_L(0); PG8_BAR; PG8_MMA(0, 0, At, B0); PG8_MMA(0, 1, At, B1); PG8_BAR; PG8_SCHED;
            PG8_LDA(At, 0, 1); PG8_STAGE(PG8_SB(0, 0), b2, voffB); PG8_STAGE(PG8_SB(0, 1), b2 + hstepB, voffB); PG8_STAGE(PG8_SA(0, 0), a2, voffA);
            PG8_WAIT_V(8); PG8_WAIT_L(0); PG8_BAR; PG8_MMA(1, 0, At, B0); PG8_MMA(1, 1, At, B1); PG8_BAR; PG8_SCHED;
            PG8_LDB(B0, 1, 0); PG8_LDB(B1, 1, 1); PG8_SCHED; PG8_LDA(At, 1, 0); PG8_STAGE(PG8_SA(0, 1), a2 + hstepA, voffA);
            PG8_WAIT_V(8); PG8_WAIT_L(0); PG8_BAR; PG8_MMA(0, 0, At, B0); PG8_MMA(0, 1, At, B1); PG8_BAR; PG8_SCHED;
            PG8_LDA(At, 1, 1); PG8_STAGE(PG8_SB(1, 0), b3, voffB); PG8_STAGE(PG8_SB(1, 1), b3 + hstepB, voffB); PG8_STAGE(PG8_SA(1, 0), a3, voffA);
            PG8_WAIT_V(8); PG8_WAIT_L(0); PG8_BAR; PG8_MMA(1, 0, At, B0); PG8_MMA(1, 1, At, B1); PG8_BAR; PG8_SCHED;
        }
        if (wr == 0) PG8_BAR;
        if constexpr (SPLIT2) {
            const bool fin = PG8_HALF(ui) == 1;
            if (fin) E(acc, cur, wr, wc, fr, fq);
            if (fin && !has_next) break;
            float fs[8]; E.scales(fs, cur, fin, wr, fr);
#pragma unroll
            for (int a = 0; a < 2; ++a)
#pragma unroll
                for (int b = 0; b < 2; ++b)
#pragma unroll
                    for (int m = 0; m < 4; ++m)
#pragma unroll
                        for (int n = 0; n < 2; ++n) acc[a][b][m][n] *= fs[a * 4 + m];
        } else {
        E(acc, cur, wr, wc, fr, fq);
        if (!has_next) break;
#pragma unroll
        for (int a = 0; a < 2; ++a)
#pragma unroll
            for (int b = 0; b < 2; ++b)
#pragma unroll
                for (int m = 0; m < 4; ++m)
#pragma unroll
                    for (int n = 0; n < 2; ++n) acc[a][b][m][n] = (f32x4){0.f, 0.f, 0.f, 0.f};
        }
        cur = nxt; cA = nA; cB = nB; ++ui;
        if (wr == 1) PG8_BAR;
    }
    PG8_WAIT_V(0);
    PG8_BAR;
#undef PG8_HALF
#undef PG8_NEXT
#undef PG8_SA
#undef PG8_SB
#undef PG8_STAGE
#undef PG8_LDA
#undef PG8_LDB
#undef PG8_MMA
#undef PG8_WAIT_V
#undef PG8_WAIT_L
#undef PG8_BAR
#undef PG8_SCHED
}
}
using pg8::Unit;
typedef f32x4 AccT[2][2][4][2];

struct EpiIn {
    static constexpr int MID_T = 0;
    bf16_t* qkvu; const float* ropec; const float* ropes;
    __device__ __forceinline__ void operator()(const AccT& acc, const Unit& u, int wr, int wc, int fr, int fq) const {
        const int t = u.pn >> 1;
        bf16_t* base = qkvu + (size_t)t * M * DH;
        const int col0 = (u.pn & 1) * 256 + wc * 32 + 8 * fq;
        const bool rope = (t < 2) && ((wc & 1) == 0);
#pragma unroll
        for (int ai = 0; ai < 2; ++ai)
#pragma unroll
            for (int m = 0; m < 4; ++m) {
                const int row = u.pm * 256 + ai * 128 + wr * 64 + m * 16 + fr;
                f32x4 v[2][2];
#pragma unroll
                for (int bj = 0; bj < 2; ++bj)
#pragma unroll
                    for (int n = 0; n < 2; ++n) v[bj][n] = acc[ai][bj][m][n];
                if (rope) {
                    const int pos = row_pos(row);
#pragma unroll
                    for (int n = 0; n < 2; ++n) {
                        const f32x4 c4 = *(const f32x4*)(ropec + pos * 8 + 4 * n), s4 = *(const f32x4*)(ropes + pos * 8 + 4 * n);
#pragma unroll
                        for (int bj = 0; bj < 2; ++bj) {
                            f32x4 o;
#pragma unroll
                            for (int e = 0; e < 4; ++e) o[e] = __shfl_xor(v[bj][n][e], 16);
                            const f32x4 r0 = v[bj][n] * c4 - o * s4, r1 = v[bj][n] * c4 + o * s4;
                            if (fq == 0) v[bj][n] = r0; else if (fq == 1) v[bj][n] = r1;
                        }
                    }
                }
#pragma unroll
                for (int bj = 0; bj < 2; ++bj) {
                    u32x4 w; w.x = cvt_pk_bf16(v[bj][0][0], v[bj][0][1]); w.y = cvt_pk_bf16(v[bj][0][2], v[bj][0][3]); w.z = cvt_pk_bf16(v[bj][1][0], v[bj][1][1]); w.w = cvt_pk_bf16(v[bj][1][2], v[bj][1][3]);
                    *(u32x4*)(base + (size_t)row * DH + col0 + bj * 128) = w;
                }
            }
    }
};
struct EpiGlu {
    static constexpr int MID_T = 0;
    const bf16_t* spre; bf16_t* mix; const float* bglu; float* ssq_s;
    __device__ __forceinline__ void operator()(const AccT& acc, const Unit& u, int wr, int wc, int fr, int fq) const {
        const int col0 = u.pn * 256 + wc * 32 + 8 * fq;
#pragma unroll
        for (int ai = 0; ai < 2; ++ai)
#pragma unroll
            for (int m = 0; m < 4; ++m) {
                const int row = u.pm * 256 + ai * 128 + wr * 64 + m * 16 + fr; float ss = 0.f;
#pragma unroll
                for (int bj = 0; bj < 2; ++bj) {
                    const int col = col0 + bj * 128;
                    const u32x4 sv = *(const u32x4*)(spre + (size_t)row * DH + col);
                    const f32x4 b0 = *(const f32x4*)(bglu + col), b1 = *(const f32x4*)(bglu + col + 4);
                    const f32x4 z0 = acc[ai][bj][m][0] + b0, z1 = acc[ai][bj][m][1] + b1;
                    float o[8];
                    o[0] = bf_lo(sv.x) * sigmoidf_(z0[0]); o[1] = bf_hi(sv.x) * sigmoidf_(z0[1]); o[2] = bf_lo(sv.y) * sigmoidf_(z0[2]); o[3] = bf_hi(sv.y) * sigmoidf_(z0[3]);
                    o[4] = bf_lo(sv.z) * sigmoidf_(z1[0]); o[5] = bf_hi(sv.z) * sigmoidf_(z1[1]); o[6] = bf_lo(sv.w) * sigmoidf_(z1[2]); o[7] = bf_hi(sv.w) * sigmoidf_(z1[3]);
#pragma unroll
                    for (int e = 0; e < 8; ++e) ss += o[e] * o[e];
                    u32x4 w; w.x = cvt_pk_bf16(o[0], o[1]); w.y = cvt_pk_bf16(o[2], o[3]); w.z = cvt_pk_bf16(o[4], o[5]); w.w = cvt_pk_bf16(o[6], o[7]);
                    *(u32x4*)(mix + (size_t)row * D + DH + col) = w;
                }
                ss += __shfl_xor(ss, 16); ss += __shfl_xor(ss, 32);
                if (fq == 0) atomicAdd(ssq_s + row, ss);
                asm volatile("" ::: "memory");
            }
    }
};
struct EpiOut {
    static constexpr int MID_T = 8;
    const float* xp; const float* xs; float* out; bf16_t* y1b; const float* ssq_a; const float* ssq_s; float* ln_sum; float* ln_sq;
    __device__ __forceinline__ void scales(float (&fs)[8], const Unit& u, bool fin, int wr, int fr) const {
#pragma unroll
        for (int i = 0; i < 8; ++i) {
            const int row = u.pm * 256 + (i >> 2) * 128 + wr * 64 + (i & 3) * 16 + fr;
            const float va = ssq_a[row] * (1.0f / DH) + LN_EPS, vs = ssq_s[row] * (1.0f / DH) + LN_EPS;
            const float f = __builtin_amdgcn_sqrtf(vs * fast_rcp(va));
            fs[i] = fin ? 0.f : f;
        }
    }
    __device__ __forceinline__ void operator()(const AccT& acc, const Unit& u, int wr, int wc, int fr, int fq) const {
        const int col0 = u.pn * 256 + wc * 32 + 8 * fq;
        const float* xb = (u.pm < MP / 256) ? xp : xs - (size_t)MP * D;
#pragma unroll
        for (int ai = 0; ai < 2; ++ai)
#pragma unroll
            for (int m = 0; m < 4; ++m) {
                const int row = u.pm * 256 + ai * 128 + wr * 64 + m * 16 + fr;
                const float rs = __builtin_amdgcn_rsqf(ssq_s[row] * (1.0f / DH) + LN_EPS);
                const size_t ro = (size_t)row * D + col0;
                float s1 = 0.f, s2 = 0.f;
#pragma unroll
                for (int bj = 0; bj < 2; ++bj)
#pragma unroll
                    for (int n = 0; n < 2; ++n) {
                        const size_t o = ro + bj * 128 + 4 * n;
                        const f32x4 x0 = *(const f32x4*)(xb + o);
                        const f32x4 y0 = x0 * DN_ALPHA + acc[ai][bj][m][n] * rs;
                        *(f32x4*)(out + o) = y0;
                        s1 += (y0[0] + y0[1]) + (y0[2] + y0[3]); s2 += (y0[0] * y0[0] + y0[1] * y0[1]) + (y0[2] * y0[2] + y0[3] * y0[3]);
                        *(u32x2*)(y1b + o) = (u32x2){cvt_pk_bf16(y0[0], y0[1]), cvt_pk_bf16(y0[2], y0[3])};
                    }
                s1 += __shfl_xor(s1, 16); s1 += __shfl_xor(s1, 32); s2 += __shfl_xor(s2, 16); s2 += __shfl_xor(s2, 32);
                if (fq == 0) { atomicAdd(ln_sum + row, s1); atomicAdd(ln_sq + row, s2); }
                asm volatile("" ::: "memory");
            }
    }
};
struct EpiUp {
    static constexpr int MID_T = 0;
    bf16_t* f; const float* gW; const float* bW; const float* convw; const float* convb; const float* ln_sum; const float* ln_sq;
    __device__ __forceinline__ void operator()(const AccT& acc, const Unit& u, int wr, int wc, int fr, int fq) const {
        const int feat0 = u.pn * 128 + wc * 32 + 8 * fq;
        const int pc0 = u.pn * 256 + wc * 32 + 8 * fq;
        const int rbase = u.pm * UP_TM + wr * 126 - 1;
        float ra[8], rb[8];
        unsigned vmask = 0, pmask = 0, nmask = 0;
#pragma unroll
        for (int i = 0; i < 8; ++i) {
            const int lr = (i >> 2) * 64 + (i & 3) * 16 + fr;
            const int rowu = rbase + lr; const int row = rowu < 0 ? 0 : (rowu >= M ? M - 1 : rowu);
            const float mu = ln_sum[row] * (1.0f / D), var = ln_sq[row] * (1.0f / D) - mu * mu, rstd = __builtin_amdgcn_rsqf(var + LN_EPS);
            ra[i] = rstd; rb[i] = -rstd * mu;
            const int pos = row_pos(row), sl = row_slen(row);
            if ((lr >= 1) && (lr <= 126) && (rowu >= 0) && (rowu < M)) vmask |= 1u << i;
            if (pos != 0) pmask |= 1u << i;
            if (pos != sl - 1) nmask |= 1u << i;
        }
#pragma unroll
        for (int n = 0; n < 2; ++n) {
            const f32x4 gWg = *(const f32x4*)(gW + pc0 + 4 * n), bWg = *(const f32x4*)(bW + pc0 + 4 * n), gWv = *(const f32x4*)(gW + pc0 + 128 + 4 * n), bWv = *(const f32x4*)(bW + pc0 + 128 + 4 * n);
            const f32x4 w0 = *(const f32x4*)(convw + feat0 + 4 * n), w1 = *(const f32x4*)(convw + FF + feat0 + 4 * n), w2 = *(const f32x4*)(convw + 2 * FF + feat0 + 4 * n), cb = *(const f32x4*)(convb + feat0 + 4 * n);
            f32x4 gp = (f32x4){0.f, 0.f, 0.f, 0.f};
            f32x4 gc = acc[0][0][0][n] * ra[0] + (gWg * rb[0] + bWg);
#pragma unroll
            for (int i = 0; i < 8; ++i) {
                f32x4 gn = gc;
                if (i < 7) gn = acc[(i + 1) >> 2][0][(i + 1) & 3][n] * ra[i + 1] + (gWg * rb[i + 1] + bWg);
                const f32x4 val = acc[i >> 2][1][i & 3][n] * ra[i] + (gWv * rb[i] + bWv);
                const bool hasp = (pmask >> i) & 1u, hasn = (nmask >> i) & 1u;
                f32x4 o;
#pragma unroll
                for (int e = 0; e < 4; ++e) {
                    const float selp = (fr == 15) ? gp[e] : gc[e];
                    const float seln = (fr == 0) ? gn[e] : gc[e];
                    float pv = dpp_f<0x121>(selp);
                    float nv = dpp_f<0x12F>(seln);
                    pv = hasp ? pv : 0.f; nv = hasn ? nv : 0.f;
                    const float cv = w0[e] * pv + w1[e] * gc[e] + w2[e] * nv + cb[e];
                    o[e] = gelu_tanh(cv) * val[e];
                }
                if ((vmask >> i) & 1u) {
                    const int row = rbase + (i >> 2) * 64 + (i & 3) * 16 + fr;
                    *(u32x2*)(f + (size_t)row * FF + feat0 + 4 * n) = (u32x2){cvt_pk_bf16(o[0], o[1]), cvt_pk_bf16(o[2], o[3])};
                }
                gp = gc; gc = gn;
            }
        }
    }
};
struct EpiDown {
    static constexpr int MID_T = 0;
    float* out; const float* g1; const float* b1; const float* ln1_sum; const float* ln1_sq; float* ln2_sum; float* ln2_sq;
    __device__ __forceinline__ void operator()(const AccT& acc, const Unit& u, int wr, int wc, int fr, int fq) const {
        const int col0 = u.pn * 256 + wc * 32 + 8 * fq;
#pragma unroll
        for (int ai = 0; ai < 2; ++ai)
#pragma unroll
            for (int m = 0; m < 4; ++m) {
                const int row = u.pm * 256 + ai * 128 + wr * 64 + m * 16 + fr;
                const float mu = ln1_sum[row] * (1.0f / D), var = ln1_sq[row] * (1.0f / D) - mu * mu, rstd = __builtin_amdgcn_rsqf(var + LN_EPS);
                float s1 = 0.f, s2 = 0.f;
#pragma unroll
                for (int bj = 0; bj < 2; ++bj)
#pragma unroll
                    for (int n = 0; n < 2; ++n) {
                        const int col = col0 + bj * 128 + 4 * n;
                        float* p = out + (size_t)row * D + col;
                        const f32x4 y1 = *(const f32x4*)p, gg = *(const f32x4*)(g1 + col), bb = *(const f32x4*)(b1 + col);
                        const f32x4 x1 = (y1 - mu) * rstd * gg + bb;
                        const f32x4 y2 = x1 * DN_ALPHA + acc[ai][bj][m][n];
                        *(f32x4*)p = y2;
#pragma unroll
                        for (int e = 0; e < 4; ++e) { s1 += y2[e]; s2 += y2[e] * y2[e]; }
                    }
                s1 += __shfl_xor(s1, 16); s1 += __shfl_xor(s1, 32); s2 += __shfl_xor(s2, 16); s2 += __shfl_xor(s2, 32);
                if (fq == 0) { atomicAdd(ln2_sum + row, s1); atomicAdd(ln2_sq + row, s2); }
                asm volatile("" ::: "memory");
            }
    }
};

__device__ __forceinline__ unsigned f2bf(float f) { unsigned u = __float_as_uint(f); return (u + 0x7fffu + ((u >> 16) & 1u)) >> 16; }
__device__ __forceinline__ unsigned pk2(float lo, float hi) { return f2bf(lo) | (f2bf(hi) << 16); }
template <int UPMAP>
__device__ __forceinline__ void p0_transpose_item(const float* W, int K, int N, bf16_t* WT, const float* ks, const float* ks2, LAS float* scr, int item, int lane) {
    const int nblk = N / 32, kb = item / nblk, nb = item % nblk, k0 = 64 * kb, n0 = 32 * nb;
#pragma unroll 8
    for (int i = 0; i < 32; ++i) { const int kk = 2 * i + (lane >> 5); float sc = 1.0f; if (ks) { const int kg = k0 + kk; sc = (ks2 && kg >= DH) ? ks2[kg - DH] : ks[kg]; }
        scr[kk * 33 + (lane & 31)] = W[(size_t)(k0 + kk) * N + n0 + (lane & 31)] * sc; }
    asm volatile("s_waitcnt lgkmcnt(0)" ::: "memory");
    const int c = lane & 7;
#pragma unroll
    for (int j = 0; j < 4; ++j) { const int n = (lane >> 3) + 8 * j; const LAS float* s = scr + (8 * c) * 33 + n;
        u32x4 o; o.x = pk2(s[0 * 33], s[1 * 33]); o.y = pk2(s[2 * 33], s[3 * 33]); o.z = pk2(s[4 * 33], s[5 * 33]); o.w = pk2(s[6 * 33], s[7 * 33]);
        int ng = n0 + n;
        if (UPMAP) { const int isv = ng >= FF, ft = isv ? ng - FF : ng; ng = 256 * (ft >> 7) + 128 * isv + (ft & 127); }
        *(u32x4*)(WT + (size_t)ng * K + k0 + 8 * c) = o; }
    asm volatile("s_waitcnt lgkmcnt(0)" ::: "memory");
}

__device__ __forceinline__ void p0_prep(const Params& P, LAS unsigned char* lds, int gw, int NGW, int lane) {
    unsigned char* ws = P.ws;
    const int wave = threadIdx.x >> 6;
    LAS float* scr = (LAS float*)(lds + wave * 16384);
    constexpr int I_IN = (D / 64) * (NIN / 32), I_GLU = (DH / 64) * (DH / 32), I_OUT = (D / 64) * (D / 32), I_UP = (D / 64) * (NUP / 32), I_DN = (FF / 64) * (D / 32);
    constexpr int NITEMS = I_IN + I_GLU + I_OUT + I_UP + I_DN;
    for (int it = gw; it < NITEMS; it += NGW) {
        int r = it;
        if (r < I_IN) { p0_transpose_item<0>(P.in[2], D, NIN, (bf16_t*)(ws + WS_WIN), nullptr, nullptr, scr, r, lane); continue; } r -= I_IN;
        if (r < I_GLU) { p0_transpose_item<0>(P.in[12], DH, DH, (bf16_t*)(ws + WS_WGLU), nullptr, nullptr, scr, r, lane); continue; } r -= I_GLU;
        if (r < I_OUT) { p0_transpose_item<0>(P.in[15], D, D, (bf16_t*)(ws + WS_WOUT), P.in[3], P.in[14], scr, r, lane); continue; } r -= I_OUT;
        if (r < I_UP) { p0_transpose_item<1>(P.in[18], D, NUP, (bf16_t*)(ws + WS_WUP), P.in[16], nullptr, scr, r, lane); continue; } r -= I_UP;
        p0_transpose_item<0>(P.in[21], FF, D, (bf16_t*)(ws + WS_WDN), nullptr, nullptr, scr, r, lane);
    }
    const int gt = gw * 64 + lane, NGT = NGW * 64;
    for (int it = gw; it < NUP / 4; it += NGW) {
        const float* w = P.in[18]; const float* g = P.in[16]; const float* b = P.in[17];
        const int n = it * 4 + (lane >> 4), kseg = lane & 15;
        float sg = 0.f, sb = 0.f;
#pragma unroll 8
        for (int kk = 0; kk < 64; ++kk) { const int k = kseg * 64 + kk; const float wv = w[(size_t)k * NUP + n]; sg += __uint_as_float(f2bf(g[k] * wv) << 16); sb += b[k] * wv; }
#pragma unroll
        for (int o = 1; o < 16; o <<= 1) { sg += __shfl_xor(sg, o); sb += __shfl_xor(sb, o); }
        if (kseg == 0) { const int isv = n >= FF, ft = isv ? n - FF : n, pc = 256 * (ft >> 7) + 128 * isv + (ft & 127);
            ((float*)(ws + WS_GW))[pc] = sg; ((float*)(ws + WS_BW))[pc] = sb; }
    }
    for (int i = gt; i < 6 * M / 4; i += NGT) ((f32x4*)(ws + WS_STATS))[i] = (f32x4){0.f, 0.f, 0.f, 0.f};
    for (int i = gt; i < 16384 * 8; i += NGT) {
        const int pos = i >> 3, j = i & 7;
        const double invf[8] = {1.0, 0.19392274474868576, 0.03760603093086393, 0.007292664737217109, 0.001414213562373095, 0.0002742481756762073, 5.318295896944988e-05, 1.031338537721246e-05};
        double fr_ = 1.0;
#pragma unroll
        for (int q = 0; q < 8; ++q) fr_ = (j == q) ? invf[q] : fr_;
        const double ang = (double)pos * fr_;
        const double k2 = rint(ang * 0.15915494309189535);
        const double red = fma(-k2, 6.283185307179586, ang) - k2 * 2.4492935982947064e-16;
        float sn, cs; sincosf((float)red, &sn, &cs);
        ((float*)(ws + WS_ROPEC))[i] = cs; ((float*)(ws + WS_ROPES))[i] = sn;
    }
    for (int i = gt; i < 2 * 32 * 64; i += NGT) {
        const int dg = i >> 6;
        const double dt = exp((double)P.in[6][dg]);
        const double are = P.in[4][i], aim = P.in[5][i];
        const double mag = exp(are * dt), ang = aim * dt;
        double lr = mag * cos(ang), li = mag * sin(ang);
        ((f32x2*)(ws + WS_LAM))[i] = (f32x2){(float)lr, (float)li};
        for (int q = 0; q < 5; ++q) { const double t = lr * lr - li * li; li = 2.0 * lr * li; lr = t; }
        ((f32x2*)(ws + WS_LAML))[i] = (f32x2){(float)lr, (float)li};
    }
    for (int i = gt; i < 2 * 32 * 8 * 64; i += NGT) {
        const int ln = i & 63, T = (i >> 6) & 7, dg = i >> 9;
        const int s = T >> 1, ri = T & 1, p = 16 * s + (ln & 15), q = ln >> 4;
        const double dt = exp((double)P.in[6][dg]);
        const double are = P.in[4][dg * 64 + p], aim = P.in[5][dg * 64 + p];
        const double mag = exp(are * dt), ang = aim * dt;
        const double lr = mag * cos(ang) - 1.0, li = mag * sin(ang);
        const double den = are * are + aim * aim;
        const double cr = (lr * are + li * aim) / den, ci = (li * are - lr * aim) / den;
        unsigned short v[8];
#pragma unroll
        for (int j = 0; j < 8; ++j) { const int c = 4 * q + (j & 3); const size_t bi = ((size_t)dg * 64 + p) * 16 + c;
            const double br = P.in[7][bi], bim = P.in[8][bi];
            const double o = ri == 0 ? (cr * br - ci * bim) : (cr * bim + ci * br);
            v[j] = j < 4 ? (unsigned short)f2bf((float)o) : (unsigned short)0; }
        ((u32x4*)(ws + WS_BFRAG))[i] = (u32x4){(unsigned)v[0] | ((unsigned)v[1] << 16), (unsigned)v[2] | ((unsigned)v[3] << 16), (unsigned)v[4] | ((unsigned)v[5] << 16), (unsigned)v[6] | ((unsigned)v[7] << 16)};
    }
    for (int i = gt; i < 32 * 5 * 64; i += NGT) {
        const int ln = i & 63, kb = (i >> 6) % 5, g = i / 320;
        const int ch = ln & 15, q = ln >> 4;
        unsigned short v[8];
#pragma unroll
        for (int jj = 0; jj < 8; ++jj) {
            if (kb < 4) { const int p = 16 * kb + 4 * q + (jj & 3); const size_t ci = ((size_t)g * 16 + ch) * 64 + p; v[jj] = (unsigned short)f2bf(jj < 4 ? P.in[9][ci] : -P.in[10][ci]); }
            else { const int c2 = 4 * q + (jj & 3); const float dv = P.in[11][g * 16 + ch]; const unsigned hi = f2bf(dv); const float lo = dv - __uint_as_float(hi << 16);
                   v[jj] = (c2 == ch) ? (unsigned short)(jj < 4 ? hi : f2bf(lo)) : (unsigned short)0; }
        }
        ((u32x4*)(ws + WS_CFRAG))[i] = (u32x4){(unsigned)v[0] | ((unsigned)v[1] << 16), (unsigned)v[2] | ((unsigned)v[3] << 16), (unsigned)v[4] | ((unsigned)v[5] << 16), (unsigned)v[6] | ((unsigned)v[7] << 16)};
    }
    for (size_t i = gt; i < (size_t)M * D / 8; i += NGT) {
        const size_t e = i * 8; const float* src = e < (size_t)MP * D ? P.in[0] + e : P.in[1] + (e - (size_t)MP * D);
        const f32x4 a = *(const f32x4*)src, b = *(const f32x4*)(src + 4);
        u32x4 w; w.x = cvt_pk_bf16(a[0], a[1]); w.y = cvt_pk_bf16(a[2], a[3]); w.z = cvt_pk_bf16(b[0], b[1]); w.w = cvt_pk_bf16(b[2], b[3]);
        ((u32x4*)(ws + WS_XB))[i] = w;
    }
}

constexpr int VROW = 144;
struct AttBuf { bf16x8 kf[2][2]; u32x4 vreg[4]; };
__device__ __forceinline__ void att_step_params(int s, int i0, int& sh, int& mb) {
    const int br = s >= 11 ? 2 : (s >= 5 ? 1 : 0), st = s - (br == 2 ? 11 : (br == 1 ? 5 : 0));
    sh = br == 0 ? 4 : (br == 1 ? 2 : 0);
    mb = ((16 >> sh) * i0) - 64 + 32 * st;
}
__device__ __forceinline__ void att_load(AttBuf& B, const bf16_t* __restrict__ Kt, const bf16_t* __restrict__ Vt, int s, int i0, int r, int S, int sbrow, int h, int lane) {
    int sh, mb; att_step_params(s, i0, sh, mb);
    const int qi = lane & 15, g4 = lane >> 4;
#pragma unroll
    for (int blk = 0; blk < 2; ++blk) {
        int tok = r + ((mb + 16 * blk + qi) << sh); tok = tok < 0 ? 0 : (tok >= S ? S - 1 : tok);
        const bf16_t* kp = Kt + (size_t)(sbrow + tok) * DH + h * 64 + 8 * g4;
        B.kf[blk][0] = *(const bf16x8*)kp; B.kf[blk][1] = *(const bf16x8*)(kp + 32);
    }
#pragma unroll
    for (int i = 0; i < 4; ++i) { const int idx = lane + 64 * i, rw = idx >> 3, ch = idx & 7;
        int tok = r + ((mb + rw) << sh); tok = tok < 0 ? 0 : (tok >= S ? S - 1 : tok);
        B.vreg[i] = *(const u32x4*)(Vt + (size_t)(sbrow + tok) * DH + h * 64 + 8 * ch); }
}
__device__ __forceinline__ void att_comp(const AttBuf& B, const bf16x8 (&qf)[2], f32x4 (&O)[4], float& mrun, float& lsum, LAS unsigned char* vl, unsigned vrd,
                                         int s, int i0, int r, int S, int lane) {
    int sh, mb; att_step_params(s, i0, sh, mb);
    const int qi = lane & 15, g4 = lane >> 4;
    const int qpos = (16 >> sh) * (i0 + qi);
    const float SC = 0.125f * 1.4426950408889634f;
    f32x4 sa[2];
#pragma unroll
    for (int blk = 0; blk < 2; ++blk) {
        sa[blk] = __builtin_amdgcn_mfma_f32_16x16x32_bf16(B.kf[blk][0], qf[0], (f32x4){0.f, 0.f, 0.f, 0.f}, 0, 0, 0);
        sa[blk] = __builtin_amdgcn_mfma_f32_16x16x32_bf16(B.kf[blk][1], qf[1], sa[blk], 0, 0, 0);
    }
#pragma unroll
    for (int i = 0; i < 4; ++i) { const int idx = lane + 64 * i, rw = idx >> 3, ch = idx & 7; *(LAS u32x4*)(vl + rw * VROW + ch * 16) = B.vreg[i]; }
    const int tlo = r + (mb << sh), thi = r + ((mb + 31) << sh);
    const bool edge = (tlo < 0) || (thi >= S);
    const int dbase = mb + 4 * g4 - qpos + 64;
    float sv[8]; float mx = -INFINITY;
#pragma unroll
    for (int blk = 0; blk < 2; ++blk)
#pragma unroll
        for (int j = 0; j < 4; ++j) {
            bool ok = (unsigned)(dbase + 16 * blk + j) <= 128u;
            if (edge) { const int tk = r + ((mb + 16 * blk + 4 * g4 + j) << sh); ok = ok && (tk >= 0) && (tk < S); }
            const float x = ok ? sa[blk][j] : -INFINITY;
            sv[blk * 4 + j] = x; mx = fmaxf(mx, x);
        }
    mx = fmaxf(mx, __shfl_xor(mx, 16)); mx = fmaxf(mx, __shfl_xor(mx, 32));
    const float mnew = fmaxf(mrun, mx * SC), alpha = fast_exp2(mrun - mnew);
    mrun = mnew;
    float p[8]; float ps = 0.f;
#pragma unroll
    for (int e = 0; e < 8; ++e) { p[e] = fast_exp2(sv[e] * SC - mnew); ps += p[e]; }
    lsum = lsum * alpha + ps;
#pragma unroll
    for (int db = 0; db < 4; ++db) O[db] *= alpha;
    bf16x8 pf;
    { const u32x4 w = (u32x4){cvt_pk_bf16(p[0], p[1]), cvt_pk_bf16(p[2], p[3]), cvt_pk_bf16(p[4], p[5]), cvt_pk_bf16(p[6], p[7])}; pf = __builtin_bit_cast(bf16x8, w); }
#pragma unroll
    for (int db = 0; db < 4; ++db) {
        typedef short v4i16_t __attribute__((ext_vector_type(4)));
        const v4i16_t lo = __builtin_amdgcn_ds_read_tr16_b64_v4i16((LAS v4i16_t*)(vl + vrd + db * 32));
        const v4i16_t hi = __builtin_amdgcn_ds_read_tr16_b64_v4i16((LAS v4i16_t*)(vl + vrd + 16 * VROW + db * 32));
        const bf16x8 vf = (bf16x8){lo[0], lo[1], lo[2], lo[3], hi[0], hi[1], hi[2], hi[3]};
        O[db] = __builtin_amdgcn_mfma_f32_16x16x32_bf16(vf, pf, O[db], 0, 0, 0);
    }
}
__device__ __forceinline__ void attn_tile(const bf16_t* __restrict__ Q, const bf16_t* __restrict__ Kt, const bf16_t* __restrict__ Vt, bf16_t* mix, float* ssq_a,
                                          LAS unsigned char* vl, int rb, int h, int r, int lane) {
    const int row0 = rb * 256;
    const int S = row_slen(row0), sbrow = row0 - row_pos(row0);
    const int i0 = row_pos(row0) >> 4;
    const int qi = lane & 15, g4 = lane >> 4;
    const int tq = r + 16 * (i0 + qi);
    bf16x8 qf[2];
#pragma unroll
    for (int kk = 0; kk < 2; ++kk) qf[kk] = *(const bf16x8*)(Q + (size_t)(sbrow + tq) * DH + h * 64 + 32 * kk + 8 * g4);
    f32x4 O[4];
#pragma unroll
    for (int db = 0; db < 4; ++db) O[db] = (f32x4){0.f, 0.f, 0.f, 0.f};
    float mrun = -1e30f, lsum = 0.f;
    const unsigned vrd = (unsigned)((4 * g4 + ((lane & 15) >> 2)) * VROW + (lane & 3) * 8);
    AttBuf B0, B1, B2;
#define ATT_LOAD(B, s) att_load(B, Kt, Vt, (s), i0, r, S, sbrow, h, lane)
#define ATT_COMP(B, s) att_comp(B, qf, O, mrun, lsum, vl, vrd, (s), i0, r, S, lane)
    ATT_LOAD(B0, 0); ATT_LOAD(B1, 1);
#pragma unroll 1
    for (int s = 0; s < 21; s += 3) {
        ATT_LOAD(B2, s + 2); ATT_COMP(B0, s);
        ATT_LOAD(B0, s + 3); ATT_COMP(B1, s + 1);
        ATT_LOAD(B1, s + 4); ATT_COMP(B2, s + 2);
    }
    ATT_COMP(B0, 21); ATT_COMP(B1, 22);
#undef ATT_LOAD
#undef ATT_COMP
    lsum += __shfl_xor(lsum, 16); lsum += __shfl_xor(lsum, 32);
    const float inv = 1.0f / lsum;
    float ss = 0.f;
    bf16_t* orow = mix + (size_t)(sbrow + tq) * D + h * 64 + 4 * g4;
#pragma unroll
    for (int db = 0; db < 4; ++db) {
        const f32x4 o = O[db] * inv;
        ss += o[0] * o[0] + o[1] * o[1] + o[2] * o[2] + o[3] * o[3];
        *(u32x2*)(orow + 16 * db) = (u32x2){cvt_pk_bf16(o[0], o[1]), cvt_pk_bf16(o[2], o[3])};
    }
    ss += __shfl_xor(ss, 16); ss += __shfl_xor(ss, 32);
    if (g4 == 0) atomicAdd(ssq_a + sbrow + tq, ss);
}

struct SsmPre { u32x2 ub[4]; float yf[4][4]; };
template <int MODE>
__device__ __forceinline__ void ssm_load(SsmPre& R, const bf16_t* __restrict__ U, const float* __restrict__ YF, unsigned uo, unsigned yo, int t0, int dir) {
    asm volatile("" : "+v"(uo), "+v"(yo));
#pragma unroll
    for (int k = 0; k < 4; ++k) {
        const unsigned tt = dir ? CL - 1 - (t0 + k) : t0 + k;
        R.ub[k] = *(const u32x2*)(U + (uo + tt * DH));
        if (MODE == 2) {
#pragma unroll
            for (int j = 0; j < 4; ++j) R.yf[k][j] = YF[yo + (j * CL + tt) * DH];
        }
    }
}
template <int MODE>
__device__ __forceinline__ void ssm_task(const Params& P, LAS unsigned char* lw, int sbk, int g, int dir, int lane) {
    unsigned char* ws = P.ws;
    const int c = lane & 15, q = lane >> 4, dg = dir * 32 + g;
    const bf16_t* U = (const bf16_t*)(ws + WS_U);
    float* YF = (float*)(ws + WS_YF);
    f32x2* ST = (f32x2*)(ws + WS_ST);
#pragma unroll
    for (int T = 0; T < 8; ++T) *(LAS u32x4*)(lw + T * 1024 + lane * 16) = ((const u32x4*)(ws + WS_BFRAG))[(dg * 8 + T) * 64 + lane];
    f32x4 lr[4], li[4], hr[4], hi[4];
#pragma unroll
    for (int s = 0; s < 4; ++s)
#pragma unroll
        for (int j = 0; j < 4; ++j) { const f32x2 l = ((const f32x2*)(ws + WS_LAM))[dg * 64 + 16 * s + 4 * q + j]; lr[s][j] = l.x; li[s][j] = l.y; hr[s][j] = 0.f; hi[s][j] = 0.f; }
    const int chunk = sbk * 16 + c;
    const size_t stbase = ((size_t)dg * NCHUNK + chunk) * 64;
    if (MODE != 0) {
#pragma unroll
        for (int s = 0; s < 4; ++s)
#pragma unroll
            for (int j = 0; j < 4; ++j) { const f32x2 v = ST[stbase + 16 * s + 4 * q + j]; hr[s][j] = v.x; hi[s][j] = v.y; }
    }
    if (MODE != 0) {
#pragma unroll
        for (int kb = 0; kb < 5; ++kb) *(LAS u32x4*)(lw + 8192 + kb * 1024 + lane * 16) = ((const u32x4*)(ws + WS_CFRAG))[(g * 5 + kb) * 64 + lane];
    }
#define BFR(T) (*(const LAS bf16x8*)(lw + (T) * 1024 + lane * 16))
#define CFR(kb) (*(const LAS bf16x8*)(lw + 8192 + (kb) * 1024 + lane * 16))
    unsigned uo = (unsigned)chunk * CL * DH + g * 16 + 4 * q;
    unsigned yo = (unsigned)(sbk * 16 + 4 * q) * CL * DH + g * 16 + c;
    SsmPre R0, R1;
#define SSM_STEP(R, k, t) do { \
        asm volatile("" : "+v"(yo) :: "memory"); \
        const bf16x8 ub = __builtin_bit_cast(bf16x8, ((u32x4){R.ub[k].x, R.ub[k].y, R.ub[k].x, R.ub[k].y})); \
        f32x4 bu[8]; \
        _Pragma("unroll") for (int T = 0; T < 8; ++T) bu[T] = __builtin_amdgcn_mfma_f32_16x16x32_bf16(BFR(T), ub, (f32x4){0.f, 0.f, 0.f, 0.f}, 0, 0, 0); \
        _Pragma("unroll") for (int s = 0; s < 4; ++s) { \
            const f32x4 nr = lr[s] * hr[s] - li[s] * hi[s] + bu[2 * s], ni = lr[s] * hi[s] + li[s] * hr[s] + bu[2 * s + 1]; \
            hr[s] = nr; hi[s] = ni; } \
        if (MODE != 0) { \
            f32x4 y = (f32x4){0.f, 0.f, 0.f, 0.f}; \
            if (MODE == 1) y = __builtin_amdgcn_mfma_f32_16x16x32_bf16(ub, CFR(4), y, 0, 0, 0); \
            _Pragma("unroll") for (int kb = 0; kb < 4; ++kb) { \
                const u32x4 w = (u32x4){cvt_pk_bf16(hr[kb][0], hr[kb][1]), cvt_pk_bf16(hr[kb][2], hr[kb][3]), cvt_pk_bf16(hi[kb][0], hi[kb][1]), cvt_pk_bf16(hi[kb][2], hi[kb][3])}; \
                y = __builtin_amdgcn_mfma_f32_16x16x32_bf16(__builtin_bit_cast(bf16x8, w), CFR(kb), y, 0, 0, 0); } \
            const unsigned tt = dir ? CL - 1 - (t) : (t); \
            _Pragma("unroll") for (int j = 0; j < 4; ++j) { \
                const unsigned oi = yo + (j * CL + tt) * DH; \
                if (MODE == 1) YF[oi] = y[j]; \
                else ((bf16_t*)(ws + WS_SPRE))[oi] = (bf16_t)(cvt_pk_bf16(gelu_tanh(y[j] + R.yf[k][j]), 0.f) & 0xffffu); } \
        } __builtin_amdgcn_sched_barrier(0); } while (0)
    ssm_load<MODE>(R0, U, YF, uo, yo, 0, dir);
#pragma unroll 1
    for (int t0 = 0; t0 < CL; t0 += 8) {
        asm volatile("" : "+v"(uo), "+v"(yo));
        ssm_load<MODE>(R1, U, YF, uo, yo, t0 + 4, dir);
        SSM_STEP(R0, 0, t0); SSM_STEP(R0, 1, t0 + 1); SSM_STEP(R0, 2, t0 + 2); SSM_STEP(R0, 3, t0 + 3);
        if (t0 + 8 < CL) ssm_load<MODE>(R0, U, YF, uo, yo, t0 + 8, dir);
        SSM_STEP(R1, 0, t0 + 4); SSM_STEP(R1, 1, t0 + 5); SSM_STEP(R1, 2, t0 + 6); SSM_STEP(R1, 3, t0 + 7);
    }
#undef SSM_STEP
#undef BFR
#undef CFR
    if (MODE == 0) {
#pragma unroll
        for (int s = 0; s < 4; ++s)
#pragma unroll
            for (int j = 0; j < 4; ++j) ST[stbase + 16 * s + 4 * q + j] = (f32x2){hr[s][j], hi[s][j]};
    }
}
__device__ __forceinline__ void ssm_carry(const Params& P, int gt, int NGT) {
    unsigned char* ws = P.ws; f32x2* ST = (f32x2*)(ws + WS_ST);
    for (int i = gt; i < 64 * 10 * 64; i += NGT) {
        const int p = i & 63, sq = (i >> 6) % 10, dg = i / 640, dir = dg >> 5;
        const int c0 = (sq < 2 ? sq * 16384 : MP + (sq - 2) * 8192) / CL, nc = (sq < 2 ? 16384 : 8192) / CL;
        const f32x2 L = ((const f32x2*)(ws + WS_LAML))[dg * 64 + p];
        f32x2 carry = (f32x2){0.f, 0.f};
        f32x2* base = ST + ((size_t)dg * NCHUNK + c0) * 64 + p;
        for (int k0 = 0; k0 < nc; k0 += 8) {
            f32x2 e[8];
#pragma unroll
            for (int k = 0; k < 8; ++k) { const int ck = dir ? nc - 1 - (k0 + k) : k0 + k; e[k] = base[(size_t)ck * 64]; }
#pragma unroll
            for (int k = 0; k < 8; ++k) { const int ck = dir ? nc - 1 - (k0 + k) : k0 + k; base[(size_t)ck * 64] = carry;
                const float cr = L.x * carry.x - L.y * carry.y + e[k].x, ci = L.x * carry.y + L.y * carry.x + e[k].y; carry = (f32x2){cr, ci}; }
        }
    }
}

constexpr int LDS_BYTES = 147456;
__global__ void __launch_bounds__(512, 2) mega_fwd(Params P, int ph_lo, int ph_hi) {
    extern __shared__ __attribute__((aligned(16))) unsigned char lds_raw[];
    LAS unsigned char* lds = (LAS unsigned char*)lds_raw;
    cg::grid_group grid = cg::this_grid();
    const int tid = threadIdx.x, lane = tid & 63, wave = __builtin_amdgcn_readfirstlane(tid >> 6);
    const int G = gridDim.x, bx = blockIdx.x;
    const int gw = bx * 8 + wave, NGW = G * 8;
    const int vgw = ((G & 7) == 0 ? (bx & 7) * (G >> 3) + (bx >> 3) : bx) * 8 + wave;
    unsigned char* ws = P.ws;
    float* stats = (float*)(ws + WS_STATS);
    float* ssq_a = stats, *ssq_s = stats + M, *ln1_sum = stats + 2 * M, *ln1_sq = stats + 3 * M, *ln2_sum = stats + 4 * M, *ln2_sq = stats + 5 * M;
#ifndef PH_MASK
#define PH_MASK 0x7ff
#endif
#define IN(k) (((PH_MASK >> (k)) & 1) && ph_lo <= (k) && (k) < ph_hi)
#define SEAM(k) do { if (ph_lo <= (k) && (k) + 1 < ph_hi) grid.sync(); } while (0)
    if (IN(0)) p0_prep(P, lds, gw, NGW, lane);
    SEAM(0);
    if (IN(1)) {
        pg8::Gemm g{(const bf16_t*)(ws + WS_XB), (const bf16_t*)(ws + WS_WIN), D}; pg8::StaticOrder S; S.init(M / 256, NIN / 256, G, bx);
        EpiIn E{(bf16_t*)(ws + WS_Q), (const float*)(ws + WS_ROPEC), (const float*)(ws + WS_ROPES)};
        pg8::gemm_phase<EpiIn, 0>(lds, g, S, E);
    }
    SEAM(1);
    if (IN(2)) {
        for (int it = bx; it < (M / 256) * 8; it += G) {
            const int rb = it >> 3, h = it & 7;
            for (int r = wave; r < 16; r += 8)
                attn_tile((const bf16_t*)(ws + WS_Q), (const bf16_t*)(ws + WS_K), (const bf16_t*)(ws + WS_V), (bf16_t*)(ws + WS_MIX), ssq_a, lds + wave * 16384, rb, h, r, lane);
        }
        for (int it = vgw; it < (M / (16 * CL)) * 64; it += NGW) ssm_task<0>(P, lds + wave * 16384, it >> 6, it & 31, (it >> 5) & 1, lane);
    }
    SEAM(2);
    if (IN(3)) ssm_carry(P, gw * 64 + lane, NGW * 64);
    SEAM(3);
    if (IN(4)) { for (int it = vgw; it < (M / (16 * CL)) * 32; it += NGW) ssm_task<1>(P, lds + wave * 16384, it >> 5, it & 31, 0, lane); }
    SEAM(4);
    if (IN(5)) { for (int it = vgw; it < (M / (16 * CL)) * 32; it += NGW) ssm_task<2>(P, lds + wave * 16384, it >> 5, it & 31, 1, lane); }
    SEAM(5);
    if (IN(6)) {
        pg8::Gemm g{(const bf16_t*)(ws + WS_SPRE), (const bf16_t*)(ws + WS_WGLU), DH}; pg8::StaticOrder S; S.init(M / 256, DH / 256, G, bx);
        EpiGlu E{(const bf16_t*)(ws + WS_SPRE), (bf16_t*)(ws + WS_MIX), P.in[13], ssq_s};
        pg8::gemm_phase<EpiGlu, 0>(lds, g, S, E);
    }
    SEAM(6);
    if (IN(7)) {
        pg8::Gemm g{(const bf16_t*)(ws + WS_MIX), (const bf16_t*)(ws + WS_WOUT), D}; pg8::StaticOrder S; S.init(M / 256, D / 256, G, bx);
        EpiOut E{P.in[0], P.in[1], P.out, (bf16_t*)(ws + WS_Y1B), ssq_a, ssq_s, ln1_sum, ln1_sq};
        pg8::gemm_phase<EpiOut, 0>(lds, g, S, E);
    }
    SEAM(7);
    if (IN(8)) {
        pg8::Gemm g{(const bf16_t*)(ws + WS_Y1B) - D, (const bf16_t*)(ws + WS_WUP), D}; pg8::StaticOrder S; S.init(UP_NM, NUP / 256, G, bx);
        EpiUp E{(bf16_t*)(ws + WS_F), (const float*)(ws + WS_GW), (const float*)(ws + WS_BW), P.in[19], P.in[20], ln1_sum, ln1_sq};
        pg8::gemm_phase<EpiUp, 1>(lds, g, S, E);
    }
    SEAM(8);
    if (IN(9)) {
        pg8::Gemm g{(const bf16_t*)(ws + WS_F), (const bf16_t*)(ws + WS_WDN), FF}; pg8::StaticOrder S; S.init(M / 256, D / 256, G, bx);
        EpiDown E{P.out, P.in[16], P.in[17], ln1_sum, ln1_sq, ln2_sum, ln2_sq};
        pg8::gemm_phase<EpiDown, 0>(lds, g, S, E);
    }
    SEAM(9);
    if (IN(10)) {
        const float* g2 = P.in[22]; const float* b2 = P.in[23];
        for (int row = gw; row < M; row += NGW) {
            const float mu = ln2_sum[row] * (1.0f / D), var = ln2_sq[row] * (1.0f / D) - mu * mu, rstd = __builtin_amdgcn_rsqf(var + LN_EPS);
            f32x4* p = (f32x4*)(P.out + (size_t)row * D) + lane;
#pragma unroll
            for (int j = 0; j < 4; ++j) { const f32x4 y = p[64 * j], gg = ((const f32x4*)g2)[64 * j + lane], bb = ((const f32x4*)b2)[64 * j + lane]; p[64 * j] = (y - mu) * rstd * gg + bb; }
        }
    }
#undef IN
#undef SEAM
}

extern "C" void kernel_launch(void* const* d_in, const int* in_sizes, int n_in, void* d_out, int out_size, void* d_ws, size_t ws_size, hipStream_t stream) {
    static int grid = 0;
    if (grid == 0) {
        if (n_in != 24 || ws_size < WS_END) { fprintf(stderr, "kernel_launch: unexpected n_in %d / ws_size %zu (need %zu)\n", n_in, ws_size, (size_t)WS_END); grid = -1; return; }
        int dev = 0, cus = 0, per_cu = 0;
        hipGetDevice(&dev); hipDeviceGetAttribute(&cus, hipDeviceAttributeMultiprocessorCount, dev);
        hipFuncSetAttribute((const void*)mega_fwd, hipFuncAttributeMaxDynamicSharedMemorySize, LDS_BYTES);
        hipOccupancyMaxActiveBlocksPerMultiprocessor(&per_cu, (const void*)mega_fwd, 512, LDS_BYTES);
        (void)hipGetLastError();
        if (per_cu < 1) per_cu = 1;
        grid = cus * per_cu;
    }
    if (grid < 0) return;
    Params p{};
    for (int i = 0; i < 24; ++i) p.in[i] = (const float*)d_in[i];
    p.out = (float*)d_out; p.ws = (unsigned char*)d_ws;
    int lo = 0, hi = 11;
    void* args[] = {&p, &lo, &hi};
    hipError_t e = hipLaunchCooperativeKernel((const void*)mega_fwd, dim3(grid), dim3(512), args, LDS_BYTES, stream);
    if (e != hipSuccess) fprintf(stderr, "cooperative launch failed: %s (grid %d)\n", hipGetErrorString(e), grid);
}
```

```cpp
#include <hip/hip_runtime.h>
#include <hip/hip_cooperative_groups.h>
#include <cstdio>
#include <cstdint>
namespace cg = cooperative_groups;

#define LAS __attribute__((address_space(3)))
typedef unsigned short bf16_t;
typedef short bf16x8 __attribute__((ext_vector_type(8)));
typedef short bf16x4 __attribute__((ext_vector_type(4)));
typedef float f32x4 __attribute__((ext_vector_type(4)));
typedef float f32x2 __attribute__((ext_vector_type(2)));
typedef unsigned u32x4 __attribute__((ext_vector_type(4)));
typedef unsigned u32x2 __attribute__((ext_vector_type(2)));

constexpr int M = 98304, D = 1024, NIN = 2048, DH = 512, FF = 2816, NUP = 5632;
constexpr int MP = 32768;
constexpr int CL = 32;
constexpr int NCHUNK = M / CL;
constexpr float LN_EPS = 1e-5f;
constexpr float DN_ALPHA = 1.189207115002721f;
constexpr int UP_TM = 252;
constexpr int UP_NM = (M + UP_TM - 1) / UP_TM;

constexpr size_t MiB = 1u << 20;
constexpr size_t WS_STATS = 0;
constexpr size_t WS_ROPEC = 3 * MiB, WS_ROPES = WS_ROPEC + 16384 * 8 * 4;
constexpr size_t WS_LAM = 4 * MiB + 0;
constexpr size_t WS_LAML = WS_LAM + 32768;
constexpr size_t WS_BFRAG = WS_LAML + 32768;
constexpr size_t WS_CFRAG = WS_BFRAG + 524288;
constexpr size_t WS_GW = WS_CFRAG + 163840;
constexpr size_t WS_BW = WS_GW + 32768;
static_assert(WS_BW + 32768 <= 5 * MiB, "tables");
constexpr size_t WS_WIN = 5 * MiB;
constexpr size_t WS_WGLU = 9 * MiB;
constexpr size_t WS_WOUT = 10 * MiB;
constexpr size_t WS_WUP = 12 * MiB;
constexpr size_t WS_WDN = 24 * MiB;
constexpr size_t WS_A = 32 * MiB;
constexpr size_t WS_XB = WS_A, WS_Q = WS_A + 192 * MiB, WS_K = WS_Q + 96 * MiB, WS_V = WS_K + 96 * MiB, WS_U = WS_V + 96 * MiB;
constexpr size_t WS_YF = WS_XB;
constexpr size_t WS_SPRE = WS_Q;
constexpr size_t WS_F = WS_A;
constexpr size_t WS_MIX = WS_A + 576 * MiB;
constexpr size_t WS_Y1B = WS_MIX + 192 * MiB + 1 * MiB;
constexpr size_t WS_ST = WS_Y1B;
constexpr size_t WS_END = WS_Y1B + 192 * MiB + 1 * MiB;
static_assert(WS_END <= 1024 * MiB, "workspace map must fit 1 GiB");
static_assert(CL == 32, "the scan's prefetch ring is written out for 8 blocks of 4 steps");

__device__ __forceinline__ unsigned cvt_pk_bf16(float lo, float hi) { unsigned r; asm volatile("v_cvt_pk_bf16_f32 %0, %1, %2" : "=v"(r) : "v"(lo), "v"(hi)); return r; }
__device__ __forceinline__ float bf_lo(unsigned w) { return __uint_as_float(w << 16); }
__device__ __forceinline__ float bf_hi(unsigned w) { return __uint_as_float(w & 0xffff0000u); }
__device__ __forceinline__ float fast_exp2(float x) { return __builtin_amdgcn_exp2f(x); }
__device__ __forceinline__ float fast_rcp(float x) { return __builtin_amdgcn_rcpf(x); }
__device__ __forceinline__ float gelu_tanh(float x) {
    const float u = x * (1.0f + 0.044715f * x * x);
    const float e = fast_exp2(u * (-2.0f * 0.7978845608028654f * 1.4426950408889634f));
    return x * fast_rcp(1.0f + e);
}
__device__ __forceinline__ float sigmoidf_(float z) { return fast_rcp(1.0f + fast_exp2(-1.4426950408889634f * z)); }
__device__ __forceinline__ int row_pos(int row) { return row < MP ? (row & 16383) : (row & 8191); }
__device__ __forceinline__ int row_slen(int row) { return row < MP ? 16384 : 8192; }
template <int CTRL> __device__ __forceinline__ float dpp_f(float v) { return __int_as_float(__builtin_amdgcn_update_dpp(0, __float_as_int(v), CTRL, 0xF, 0xF, false)); }

struct Params {
    const float* in[24];
    float* out;
    unsigned char* ws;
};
typedef const __attribute__((address_space(4))) Params* KP;

namespace pg8 {
constexpr int BM = 256, BK = 64, HALF = 128, HTB = HALF * BK * 2, STAGE_BYTES = 8 * HTB, NXCD = 8, WGM = 8;
__device__ __forceinline__ int lds_byte(int r, int c) { const int st = (r >> 4) * 2 + (c >> 5), rr = r & 15, cc = c & 31, ob = rr * 64 + cc * 2; return st * 1024 + (ob ^ (((ob >> 9) & 1) << 5)); }
__device__ __forceinline__ void stage_rc(int b, int& R, int& C) { const int st = b / 1024, sb = b % 1024, swz = sb ^ (((sb >> 9) & 1) << 5); R = (st >> 1) * 16 + swz / 64; C = (st & 1) * 32 + (swz % 64) / 2; }
__device__ __forceinline__ int perm32(int rho) { const int n = rho >> 4, i = rho & 15; return 8 * (i >> 2) + 4 * n + (i & 3); }
struct Unit { int pm, pn; };
struct Gemm { const bf16_t* A; const bf16_t* Bt; int K; };
struct StaticOrder {
    int nM, nN, nwg, G, c;
    __device__ void init(int nM_, int nN_, int G_, int c_) { nM = nM_; nN = nN_; nwg = nM * nN; G = G_; c = c_; }
    __device__ bool next(int i, Unit& u) const {
        const long L = (long)i * G + c; if (L >= nwg) return false;
        int wgid = (int)L; { const int q = nwg / NXCD, r = nwg % NXCD, xcd = wgid % NXCD, off = wgid / NXCD; wgid = (xcd < r ? xcd * (q + 1) : r * (q + 1) + (xcd - r) * q) + off; }
        const int nig = WGM * nN, gid = wgid / nig, fm = gid * WGM, gsz = (nM - fm) < WGM ? (nM - fm) : WGM;
        u.pm = fm + ((wgid % nig) % gsz); u.pn = (wgid % nig) / gsz; return true;
    }
};

template <class Epi, int AMODE>
__device__ __forceinline__ void gemm_phase(LAS unsigned char* lds, const Gemm g, const StaticOrder& S, const Epi& E) {
    const int tid = threadIdx.x, wid = __builtin_amdgcn_readfirstlane(tid >> 6), lane = tid & 63, wr = wid >> 2, wc = wid & 3, fr = lane & 15, fq = lane >> 4;
    constexpr bool SPLIT2 = Epi::MID_T > 0;
    const int K = g.K, nt = SPLIT2 ? K / BK / 2 : K / BK;
    const size_t koff = (size_t)K;
    unsigned voffA[2], voffB[2];
#pragma unroll
    for (int i = 0; i < 2; ++i) { int R, C; stage_rc(tid * 16 + i * 8192, R, C); const int Rb = (R & ~31) + perm32(R & 31);
        const int Ra = AMODE ? (126 * (R >> 6) + (R & 63)) : R;
        voffA[i] = (unsigned)(Ra * K + C) * 2u; voffB[i] = (unsigned)(Rb * K + C) * 2u; }
    const size_t kstep = (size_t)(BK * 2);
    const size_t hstepB = (size_t)HALF * K * 2, tstepB = 2 * hstepB;
    const size_t hstepA = AMODE ? (size_t)64 * K * 2 : hstepB, tstepA = AMODE ? (size_t)UP_TM * K * 2 : tstepB;
    const unsigned ldsw = (unsigned)wid * 1024u;
    const int aoff = lds_byte(wr * 64 + fr, fq * 8), boff = lds_byte(wc * 32 + fr, fq * 8);
#define PG8_SA(b, h) (((b) * 2 + (h)) * HTB)
#define PG8_SB(b, h) ((4 + (b) * 2 + (h)) * HTB)
#define PG8_STAGE(bufoff, gbase, voff) do { _Pragma("unroll") for (int _i = 0; _i < 2; ++_i) \
        __builtin_amdgcn_global_load_lds((const unsigned*)((const char*)(gbase) + (voff)[_i]), (LAS unsigned*)(lds + (bufoff) + ldsw + _i * 8192), 16, 0, 0); } while (0)
#define PG8_LDA(dst, b, h) do { _Pragma("unroll") for (int m = 0; m < 4; ++m) _Pragma("unroll") for (int k = 0; k < 2; ++k) dst[m][k] = *(const LAS bf16x8*)(lds + PG8_SA(b, h) + aoff + m * 2048 + k * 1024); } while (0)
#define PG8_LDB(dst, b, h) do { _Pragma("unroll") for (int n = 0; n < 2; ++n) _Pragma("unroll") for (int k = 0; k < 2; ++k) dst[n][k] = *(const LAS bf16x8*)(lds + PG8_SB(b, h) + boff + n * 2048 + k * 1024); } while (0)
#define PG8_MMA(ai, bj, At, Bt) do { __builtin_amdgcn_s_setprio(1); _Pragma("unroll") for (int m = 0; m < 4; ++m) _Pragma("unroll") for (int n = 0; n < 2; ++n) _Pragma("unroll") for (int k = 0; k < 2; ++k) \
        acc[ai][bj][m][n] = __builtin_amdgcn_mfma_f32_16x16x32_bf16(Bt[n][k], At[m][k], acc[ai][bj][m][n], 0, 0, 0); __builtin_amdgcn_s_setprio(0); } while (0)
#define PG8_WAIT_V(n) asm volatile("s_waitcnt vmcnt(" #n ")" ::: "memory")
#define PG8_WAIT_L(n) asm volatile("s_waitcnt lgkmcnt(" #n ")" ::: "memory")
#define PG8_BAR __builtin_amdgcn_s_barrier()
#define PG8_SCHED __builtin_amdgcn_sched_barrier(0)
    Unit cur, nxt; int ui = 0;
    if (!S.next(0, cur)) return;
#define PG8_HALF(i) (SPLIT2 ? ((i) & 1) : 0)
#define PG8_NEXT(i, u) (SPLIT2 ? S.next((i) >> 1, u) : S.next((i), u))
    f32x4 acc[2][2][4][2];
#pragma unroll
    for (int a = 0; a < 2; ++a)
#pragma unroll
        for (int b = 0; b < 2; ++b)
#pragma unroll
            for (int m = 0; m < 4; ++m)
#pragma unroll
                for (int n = 0; n < 2; ++n) acc[a][b][m][n] = (f32x4){0.f, 0.f, 0.f, 0.f};
    bf16x8 At[4][2], B0[2][2], B1[2][2];
    const char* cA = (const char*)g.A + (size_t)cur.pm * tstepA; const char* cB = (const char*)g.Bt + (size_t)cur.pn * tstepB;
    PG8_STAGE(PG8_SB(0, 0), cB, voffB); PG8_STAGE(PG8_SB(0, 1), cB + hstepB, voffB); PG8_STAGE(PG8_SA(0, 0), cA, voffA); PG8_STAGE(PG8_SA(0, 1), cA + hstepA, voffA);
    if (wr == 1) PG8_BAR;
    PG8_WAIT_V(2); PG8_BAR;
    PG8_STAGE(PG8_SB(1, 0), cB + kstep, voffB); PG8_STAGE(PG8_SA(1, 0), cA + kstep, voffA); PG8_STAGE(PG8_SB(1, 1), cB + hstepB + kstep, voffB);
    PG8_WAIT_V(6); PG8_BAR;
    for (;;) {
        const bool has_next = PG8_NEXT(ui + 1, nxt);
        const char* nA = has_next ? (const char*)g.A + (size_t)nxt.pm * tstepA + PG8_HALF(ui + 1) * koff : cA; const char* nB = has_next ? (const char*)g.Bt + (size_t)nxt.pn * tstepB + PG8_HALF(ui + 1) * koff : cB;
        for (int t = 0; t < nt; t += 2) {
            const bool last = (t == nt - 2);
            const char* a1 = cA + (size_t)(t + 1) * kstep;
            const char* a2 = last ? nA : cA + (size_t)(t + 2) * kstep; const char* b2 = last ? nB : cB + (size_t)(t + 2) * kstep;
            const char* a3 = a2 + kstep; const char* b3 = b2 + kstep;
            PG8_LDB(B0, 0, 0); PG8_LDB(B1, 0, 1); PG8_SCHED; PG8_LDA(At, 0, 0); PG8_STAGE(PG8_SA(1, 1), a1 + hstepA, voffA);
            PG8_WAIT_V(8); PG8_WAIT_L(0); PG8_BAR; PG8_MMA(0, 0, At, B0); PG8_MMA(0, 1, At, B1); PG8_BAR; PG8_SCHED;
            PG8_LDA(At, 0, 1); PG8_STAGE(PG8_SB(0, 0), b2, voffB); PG8_STAGE(PG8_SB(0, 1), b2 + hstepB, voffB); PG8_STAGE(PG8_SA(0, 0), a2, voffA);
            PG8_WAIT_V(8); PG8_WAIT_L(0); PG8_BAR; PG8_MMA(1, 0, At, B0); PG8_MMA(1, 1, At, B1); PG8_BAR; PG8_SCHED;
            PG8_LDB(B0, 1, 0); PG8_LDB(B1, 1, 1); PG8_SCHED; PG8_LDA(At, 1, 0); PG8_STAGE(PG8_SA(0, 1), a2 + hstepA, voffA);
            PG8_WAIT_V(8); PG8_WAIT_L(0); PG8_BAR; PG8_MMA(0, 0, At, B0); PG8_MMA(0, 1, At, B1); PG8_BAR; PG8_SCHED;
            PG8_LDA(At, 1, 1); PG8_STAGE(PG8_SB(1, 0), b3, voffB); PG8_STAGE(PG8_SB(1, 1), b3 + hstepB, voffB); PG8_STAGE(PG8_SA(1, 0), a3, voffA);
            PG8_WAIT_V(8); PG8_WAIT_L(0); PG8_BAR; PG8_MMA(1, 0, At, B0); PG8_MMA(1, 1, At, B1); PG8_BAR; PG8_SCHED;
        }
        if (wr == 0) PG8_BAR;
        if constexpr (SPLIT2) {
            const bool fin = PG8_HALF(ui) == 1;
            if (fin) E(acc, cur, wr, wc, fr, fq);
            if (fin && !has_next) break;
            float fs[8]; E.scales(fs, cur, fin, wr, fr);
#pragma unroll
            for (int a = 0; a < 2; ++a)
#pragma unroll
                for (int b = 0; b < 2; ++b)
#pragma unroll
                    for (int m = 0; m < 4; ++m)
#pragma unroll
                        for (int n = 0; n < 2; ++n) acc[a][b][m][n] *= fs[a * 4 + m];
        } else {
        E(acc, cur, wr, wc, fr, fq);
        if (!has_next) break;
#pragma unroll
        for (int a = 0; a < 2; ++a)
#pragma unroll
            for (int b = 0; b < 2; ++b)
#pragma unroll
                for (int m = 0; m < 4; ++m)
#pragma unroll
                    for (int n = 0; n < 2; ++n) acc[a][b][m][n] = (f32x4){0.f, 0.f, 0.f, 0.f};
        }
        cur = nxt; cA = nA; cB = nB; ++ui;
        if (wr == 1) PG8_BAR;
    }
    PG8_WAIT_V(0);
    PG8_BAR;
#undef PG8_HALF
#undef PG8_NEXT
#undef PG8_SA
#undef PG8_SB
#undef PG8_STAGE
#undef PG8_LDA
#undef PG8_LDB
#undef PG8_MMA
#undef PG8_WAIT_V
#undef PG8_WAIT_L
#undef PG8_BAR
#undef PG8_SCHED
}
}
using pg8::Unit;
typedef f32x4 AccT[2][2][4][2];

struct EpiIn {
    static constexpr int MID_T = 0;
    bf16_t* qkvu; const float* ropec; const float* ropes;
    __device__ __forceinline__ void operator()(const AccT& acc, const Unit& u, int wr, int wc, int fr, int fq) const {
        const int t = u.pn >> 1;
        bf16_t* base = qkvu + (size_t)t * M * DH;
        const int col0 = (u.pn & 1) * 256 + wc * 32 + 8 * fq;
        const bool rope = (t < 2) && ((wc & 1) == 0);
#pragma unroll
        for (int ai = 0; ai < 2; ++ai)
#pragma unroll
            for (int m = 0; m < 4; ++m) {
                const int row = u.pm * 256 + ai * 128 + wr * 64 + m * 16 + fr;
                f32x4 v[2][2];
#pragma unroll
                for (int bj = 0; bj < 2; ++bj)
#pragma unroll
                    for (int n = 0; n < 2; ++n) v[bj][n] = acc[ai][bj][m][n];
                if (rope) {
                    const int pos = row_pos(row);
#pragma unroll
                    for (int n = 0; n < 2; ++n) {
                        const f32x4 c4 = *(const f32x4*)(ropec + pos * 8 + 4 * n), s4 = *(const f32x4*)(ropes + pos * 8 + 4 * n);
#pragma unroll
                        for (int bj = 0; bj < 2; ++bj) {
                            f32x4 o;
#pragma unroll
                            for (int e = 0; e < 4; ++e) o[e] = __shfl_xor(v[bj][n][e], 16);
                            const f32x4 r0 = v[bj][n] * c4 - o * s4, r1 = v[bj][n] * c4 + o * s4;
                            if (fq == 0) v[bj][n] = r0; else if (fq == 1) v[bj][n] = r1;
                        }
                    }
                }
#pragma unroll
                for (int bj = 0; bj < 2; ++bj) {
                    u32x4 w; w.x = cvt_pk_bf16(v[bj][0][0], v[bj][0][1]); w.y = cvt_pk_bf16(v[bj][0][2], v[bj][0][3]); w.z = cvt_pk_bf16(v[bj][1][0], v[bj][1][1]); w.w = cvt_pk_bf16(v[bj][1][2], v[bj][1][3]);
                    *(u32x4*)(base + (size_t)row * DH + col0 + bj * 128) = w;
                }
            }
    }
};
struct EpiGlu {
    static constexpr int MID_T = 0;
    const bf16_t* spre; bf16_t* mix; const float* bglu; float* ssq_s;
    __device__ __forceinline__ void operator()(const AccT& acc, const Unit& u, int wr, int wc, int fr, int fq) const {
        const int col0 = u.pn * 256 + wc * 32 + 8 * fq;
#pragma unroll
        for (int ai = 0; ai < 2; ++ai)
#pragma unroll
            for (int m = 0; m < 4; ++m) {
                const int row = u.pm * 256 + ai * 128 + wr * 64 + m * 16 + fr; float ss = 0.f;
#pragma unroll
                for (int bj = 0; bj < 2; ++bj) {
                    const int col = col0 + bj * 128;
                    const u32x4 sv = *(const u32x4*)(spre + (size_t)row * DH + col);
                    const f32x4 b0 = *(const f32x4*)(bglu + col), b1 = *(const f32x4*)(bglu + col + 4);
                    const f32x4 z0 = acc[ai][bj][m][0] + b0, z1 = acc[ai][bj][m][1] + b1;
                    float o[8];
                    o[0] = bf_lo(sv.x) * sigmoidf_(z0[0]); o[1] = bf_hi(sv.x) * sigmoidf_(z0[1]); o[2] = bf_lo(sv.y) * sigmoidf_(z0[2]); o[3] = bf_hi(sv.y) * sigmoidf_(z0[3]);
                    o[4] = bf_lo(sv.z) * sigmoidf_(z1[0]); o[5] = bf_hi(sv.z) * sigmoidf_(z1[1]); o[6] = bf_lo(sv.w) * sigmoidf_(z1[2]); o[7] = bf_hi(sv.w) * sigmoidf_(z1[3]);
#pragma unroll
                    for (int e = 0; e < 8; ++e) ss += o[e] * o[e];
                    u32x4 w; w.x = cvt_pk_bf16(o[0], o[1]); w.y = cvt_pk_bf16(o[2], o[3]); w.z = cvt_pk_bf16(o[4], o[5]); w.w = cvt_pk_bf16(o[6], o[7]);
                    *(u32x4*)(mix + (size_t)row * D + DH + col) = w;
                }
                ss += __shfl_xor(ss, 16); ss += __shfl_xor(ss, 32);
                if (fq == 0) atomicAdd(ssq_s + row, ss);
                asm volatile("" ::: "memory");
            }
    }
};
struct EpiOut {
    static constexpr int MID_T = 8;
    const float* xp; const float* xs; float* out; bf16_t* y1b; const float* ssq_a; const float* ssq_s; float* ln_sum; float* ln_sq;
    __device__ __forceinline__ void scales(float (&fs)[8], const Unit& u, bool fin, int wr, int fr) const {
#pragma unroll
        for (int i = 0; i < 8; ++i) {
            const int row = u.pm * 256 + (i >> 2) * 128 + wr * 64 + (i & 3) * 16 + fr;
            const float va = ssq_a[row] * (1.0f / DH) + LN_EPS, vs = ssq_s[row] * (1.0f / DH) + LN_EPS;
            const float f = __builtin_amdgcn_sqrtf(vs * fast_rcp(va));
            fs[i] = fin ? 0.f : f;
        }
    }
    __device__ __forceinline__ void operator()(const AccT& acc, const Unit& u, int wr, int wc, int fr, int fq) const {
        const int col0 = u.pn * 256 + wc * 32 + 8 * fq;
        const float* xb = (u.pm < MP / 256) ? xp : xs - (size_t)MP * D;
#pragma unroll
        for (int ai = 0; ai < 2; ++ai)
#pragma unroll
            for (int m = 0; m < 4; ++m) {
                const int row = u.pm * 256 + ai * 128 + wr * 64 + m * 16 + fr;
                const float rs = __builtin_amdgcn_rsqf(ssq_s[row] * (1.0f / DH) + LN_EPS);
                const size_t ro = (size_t)row * D + col0;
                float s1 = 0.f, s2 = 0.f;
#pragma unroll
                for (int bj = 0; bj < 2; ++bj)
#pragma unroll
                    for (int n = 0; n < 2; ++n) {
                        const size_t o = ro + bj * 128 + 4 * n;
                        const f32x4 x0 = *(const f32x4*)(xb + o);
                        const f32x4 y0 = x0 * DN_ALPHA + acc[ai][bj][m][n] * rs;
                        *(f32x4*)(out + o) = y0;
                        s1 += (y0[0] + y0[1]) + (y0[2] + y0[3]); s2 += (y0[0] * y0[0] + y0[1] * y0[1]) + (y0[2] * y0[2] + y0[3] * y0[3]);
                        *(u32x2*)(y1b + o) = (u32x2){cvt_pk_bf16(y0[0], y0[1]), cvt_pk_bf16(y0[2], y0[3])};
                    }
                s1 += __shfl_xor(s1, 16); s1 += __shfl_xor(s1, 32); s2 += __shfl_xor(s2, 16); s2 += __shfl_xor(s2, 32);
                if (fq == 0) { atomicAdd(ln_sum + row, s1); atomicAdd(ln_sq + row, s2); }
                asm volatile("" ::: "memory");
            }
    }
};
struct EpiUp {
    static constexpr int MID_T = 0;
    bf16_t* f; const float* gW; const float* bW; const float* convw; const float* convb; const float* ln_sum; const float* ln_sq;
    __device__ __forceinline__ void operator()(const AccT& acc, const Unit& u, int wr, int wc, int fr, int fq) const {
        const int feat0 = u.pn * 128 + wc * 32 + 8 * fq;
        const int pc0 = u.pn * 256 + wc * 32 + 8 * fq;
        const int rbase = u.pm * UP_TM + wr * 126 - 1;
        float ra[8], rb[8];
        unsigned vmask = 0, pmask = 0, nmask = 0;
#pragma unroll
        for (int i = 0; i < 8; ++i) {
            const int lr = (i >> 2) * 64 + (i & 3) * 16 + fr;
            const int rowu = rbase + lr; const int row = rowu < 0 ? 0 : (rowu >= M ? M - 1 : rowu);
            const float mu = ln_sum[row] * (1.0f / D), var = ln_sq[row] * (1.0f / D) - mu * mu, rstd = __builtin_amdgcn_rsqf(var + LN_EPS);
            ra[i] = rstd; rb[i] = -rstd * mu;
            const int pos = row_pos(row), sl = row_slen(row);
            if ((lr >= 1) && (lr <= 126) && (rowu >= 0) && (rowu < M)) vmask |= 1u << i;
            if (pos != 0) pmask |= 1u << i;
            if (pos != sl - 1) nmask |= 1u << i;
        }
#pragma unroll
        for (int n = 0; n < 2; ++n) {
            const f32x4 gWg = *(const f32x4*)(gW + pc0 + 4 * n), bWg = *(const f32x4*)(bW + pc0 + 4 * n), gWv = *(const f32x4*)(gW + pc0 + 128 + 4 * n), bWv = *(const f32x4*)(bW + pc0 + 128 + 4 * n);
            const f32x4 w0 = *(const f32x4*)(convw + feat0 + 4 * n), w1 = *(const f32x4*)(convw + FF + feat0 + 4 * n), w2 = *(const f32x4*)(convw + 2 * FF + feat0 + 4 * n), cb = *(const f32x4*)(convb + feat0 + 4 * n);
            f32x4 gp = (f32x4){0.f, 0.f, 0.f, 0.f};
            f32x4 gc = acc[0][0][0][n] * ra[0] + (gWg * rb[0] + bWg);
#pragma unroll
            for (int i = 0; i < 8; ++i) {
                f32x4 gn = gc;
                if (i < 7) gn = acc[(i + 1) >> 2][0][(i + 1) & 3][n] * ra[i + 1] + (gWg * rb[i + 1] + bWg);
                const f32x4 val = acc[i >> 2][1][i & 3][n] * ra[i] + (gWv * rb[i] + bWv);
                const bool hasp = (pmask >> i) & 1u, hasn = (nmask >> i) & 1u;
                f32x4 o;
#pragma unroll
                for (int e = 0; e < 4; ++e) {
                    const float selp = (fr == 15) ? gp[e] : gc[e];
                    const float seln = (fr == 0) ? gn[e] : gc[e];
                    float pv = dpp_f<0x121>(selp);
                    float nv = dpp_f<0x12F>(seln);
                    pv = hasp ? pv : 0.f; nv = hasn ? nv : 0.f;
                    const float cv = w0[e] * pv + w1[e] * gc[e] + w2[e] * nv + cb[e];
                    o[e] = gelu_tanh(cv) * val[e];
                }
                if ((vmask >> i) & 1u) {
                    const int row = rbase + (i >> 2) * 64 + (i & 3) * 16 + fr;
                    *(u32x2*)(f + (size_t)row * FF + feat0 + 4 * n) = (u32x2){cvt_pk_bf16(o[0], o[1]), cvt_pk_bf16(o[2], o[3])};
                }
                gp = gc; gc = gn;
            }
        }
    }
};
struct EpiDown {
    static constexpr int MID_T = 0;
    float* out; const float* g1; const float* b1; const float* ln1_sum; const float* ln1_sq; float* ln2_sum; float* ln2_sq;
    __device__ __forceinline__ void operator()(const AccT& acc, const Unit& u, int wr, int wc, int fr, int fq) const {
        const int col0 = u.pn * 256 + wc * 32 + 8 * fq;
#pragma unroll
        for (int ai = 0; ai < 2; ++ai)
#pragma unroll
            for (int m = 0; m < 4; ++m) {
                const int row = u.pm * 256 + ai * 128 + wr * 64 + m * 16 + fr;
                const float mu = ln1_sum[row] * (1.0f / D), var = ln1_sq[row] * (1.0f / D) - mu * mu, rstd = __builtin_amdgcn_rsqf(var + LN_EPS);
                float s1 = 0.f, s2 = 0.f;
#pragma unroll
                for (int bj = 0; bj < 2; ++bj)
#pragma unroll
                    for (int n = 0; n < 2; ++n) {
                        const int col = col0 + bj * 128 + 4 * n;
                        float* p = out + (size_t)row * D + col;
                        const f32x4 y1 = *(const f32x4*)p, gg = *(const f32x4*)(g1 + col), bb = *(const f32x4*)(b1 + col);
                        const f32x4 x1 = (y1 - mu) * rstd * gg + bb;
                        const f32x4 y2 = x1 * DN_ALPHA + acc[ai][bj][m][n];
                        *(f32x4*)p = y2;
#pragma unroll
                        for (int e = 0; e < 4; ++e) { s1 += y2[e]; s2 += y2[e] * y2[e]; }
                    }
                s1 += __shfl_xor(s1, 16); s1 += __shfl_xor(s1, 32); s2 += __shfl_xor(s2, 16); s2 += __shfl_xor(s2, 32);
                if (fq == 0) { atomicAdd(ln2_sum + row, s1); atomicAdd(ln2_sq + row, s2); }
                asm volatile("" ::: "memory");
            }
    }
};

__device__ __forceinline__ unsigned f2bf(float f) { unsigned u = __float_as_uint(f); return (u + 0x7fffu + ((u >> 16) & 1u)) >> 16; }
__device__ __forceinline__ unsigned pk2(float lo, float hi) { return f2bf(lo) | (f2bf(hi) << 16); }
template <int UPMAP>
__device__ __forceinline__ void p0_transpose_item(const float* W, int K, int N, bf16_t* WT, const float* ks, const float* ks2, LAS float* scr, int item, int lane) {
    const int nblk = N / 32, kb = item / nblk, nb = item % nblk, k0 = 64 * kb, n0 = 32 * nb;
#pragma unroll 8
    for (int i = 0; i < 32; ++i) { const int kk = 2 * i + (lane >> 5); float sc = 1.0f; if (ks) { const int kg = k0 + kk; sc = (ks2 && kg >= DH) ? ks2[kg - DH] : ks[kg]; }
        scr[kk * 33 + (lane & 31)] = W[(size_t)(k0 + kk) * N + n0 + (lane & 31)] * sc; }
    asm volatile("s_waitcnt lgkmcnt(0)" ::: "memory");
    const int c = lane & 7;
#pragma unroll
    for (int j = 0; j < 4; ++j) { const int n = (lane >> 3) + 8 * j; const LAS float* s = scr + (8 * c) * 33 + n;
        u32x4 o; o.x = pk2(s[0 * 33], s[1 * 33]); o.y = pk2(s[2 * 33], s[3 * 33]); o.z = pk2(s[4 * 33], s[5 * 33]); o.w = pk2(s[6 * 33], s[7 * 33]);
        int ng = n0 + n;
        if (UPMAP) { const int isv = ng >= FF, ft = isv ? ng - FF : ng; ng = 256 * (ft >> 7) + 128 * isv + (ft & 127); }
        *(u32x4*)(WT + (size_t)ng * K + k0 + 8 * c) = o; }
    asm volatile("s_waitcnt lgkmcnt(0)" ::: "memory");
}

__device__ __forceinline__ void p0_prep(KP P, LAS unsigned char* lds, int gw, int NGW, int lane) {
    unsigned char* ws = P->ws;
    const int wave = threadIdx.x >> 6;
    LAS float* scr = (LAS float*)(lds + wave * 16384);
    constexpr int I_IN = (D / 64) * (NIN / 32), I_GLU = (DH / 64) * (DH / 32), I_OUT = (D / 64) * (D / 32), I_UP = (D / 64) * (NUP / 32), I_DN = (FF / 64) * (D / 32);
    constexpr int NITEMS = I_IN + I_GLU + I_OUT + I_UP + I_DN;
    for (int it = gw; it < NITEMS; it += NGW) {
        int r = it;
        if (r < I_IN) { p0_transpose_item<0>(P->in[2], D, NIN, (bf16_t*)(ws + WS_WIN), nullptr, nullptr, scr, r, lane); continue; } r -= I_IN;
        if (r < I_GLU) { p0_transpose_item<0>(P->in[12], DH, DH, (bf16_t*)(ws + WS_WGLU), nullptr, nullptr, scr, r, lane); continue; } r -= I_GLU;
        if (r < I_OUT) { p0_transpose_item<0>(P->in[15], D, D, (bf16_t*)(ws + WS_WOUT), P->in[3], P->in[14], scr, r, lane); continue; } r -= I_OUT;
        if (r < I_UP) { p0_transpose_item<1>(P->in[18], D, NUP, (bf16_t*)(ws + WS_WUP), P->in[16], nullptr, scr, r, lane); continue; } r -= I_UP;
        p0_transpose_item<0>(P->in[21], FF, D, (bf16_t*)(ws + WS_WDN), nullptr, nullptr, scr, r, lane);
    }
    const int gt = gw * 64 + lane, NGT = NGW * 64;
    for (int it = gw; it < NUP / 4; it += NGW) {
        const float* w = P->in[18]; const float* g = P->in[16]; const float* b = P->in[17];
        const int n = it * 4 + (lane >> 4), kseg = lane & 15;
        float sg = 0.f, sb = 0.f;
#pragma unroll 8
        for (int kk = 0; kk < 64; ++kk) { const int k = kseg * 64 + kk; const float wv = w[(size_t)k * NUP + n]; sg += __uint_as_float(f2bf(g[k] * wv) << 16); sb += b[k] * wv; }
#pragma unroll
        for (int o = 1; o < 16; o <<= 1) { sg += __shfl_xor(sg, o); sb += __shfl_xor(sb, o); }
        if (kseg == 0) { const int isv = n >= FF, ft = isv ? n - FF : n, pc = 256 * (ft >> 7) + 128 * isv + (ft & 127);
            ((float*)(ws + WS_GW))[pc] = sg; ((float*)(ws + WS_BW))[pc] = sb; }
    }
    for (int i = gt; i < 6 * M / 4; i += NGT) ((f32x4*)(ws + WS_STATS))[i] = (f32x4){0.f, 0.f, 0.f, 0.f};
    for (int i = gt; i < 16384 * 8; i += NGT) {
        const int pos = i >> 3, j = i & 7;
        const double invf[8] = {1.0, 0.19392274474868576, 0.03760603093086393, 0.007292664737217109, 0.001414213562373095, 0.0002742481756762073, 5.318295896944988e-05, 1.031338537721246e-05};
        double fr_ = 1.0;
#pragma unroll
        for (int q = 0; q < 8; ++q) fr_ = (j == q) ? invf[q] : fr_;
        const double ang = (double)pos * fr_;
        const double k2 = rint(ang * 0.15915494309189535);
        const double red = fma(-k2, 6.283185307179586, ang) - k2 * 2.4492935982947064e-16;
        float sn, cs; sincosf((float)red, &sn, &cs);
        ((float*)(ws + WS_ROPEC))[i] = cs; ((float*)(ws + WS_ROPES))[i] = sn;
    }
    for (int i = gt; i < 2 * 32 * 64; i += NGT) {
        const int dg = i >> 6;
        const double dt = exp((double)P->in[6][dg]);
        const double are = P->in[4][i], aim = P->in[5][i];
        const double mag = exp(are * dt), ang = aim * dt;
        double lr = mag * cos(ang), li = mag * sin(ang);
        ((f32x2*)(ws + WS_LAM))[i] = (f32x2){(float)lr, (float)li};
        for (int q = 0; q < 5; ++q) { const double t = lr * lr - li * li; li = 2.0 * lr * li; lr = t; }
        ((f32x2*)(ws + WS_LAML))[i] = (f32x2){(float)lr, (float)li};
    }
    for (int i = gt; i < 2 * 32 * 8 * 64; i += NGT) {
        const int ln = i & 63, T = (i >> 6) & 7, dg = i >> 9;
        const int s = T >> 1, ri = T & 1, p = 16 * s + (ln & 15), q = ln >> 4;
        const double dt = exp((double)P->in[6][dg]);
        const double are = P->in[4][dg * 64 + p], aim = P->in[5][dg * 64 + p];
        const double mag = exp(are * dt), ang = aim * dt;
        const double lr = mag * cos(ang) - 1.0, li = mag * sin(ang);
        const double den = are * are + aim * aim;
        const double cr = (lr * are + li * aim) / den, ci = (li * are - lr * aim) / den;
        unsigned short v[8];
#pragma unroll
        for (int j = 0; j < 8; ++j) { const int c = 4 * q + (j & 3); const size_t bi = ((size_t)dg * 64 + p) * 16 + c;
            const double br = P->in[7][bi], bim = P->in[8][bi];
            const double o = ri == 0 ? (cr * br - ci * bim) : (cr * bim + ci * br);
            v[j] = j < 4 ? (unsigned short)f2bf((float)o) : (unsigned short)0; }
        ((u32x4*)(ws + WS_BFRAG))[i] = (u32x4){(unsigned)v[0] | ((unsigned)v[1] << 16), (unsigned)v[2] | ((unsigned)v[3] << 16), (unsigned)v[4] | ((unsigned)v[5] << 16), (unsigned)v[6] | ((unsigned)v[7] << 16)};
    }
    for (int i = gt; i < 32 * 5 * 64; i += NGT) {
        const int ln = i & 63, kb = (i >> 6) % 5, g = i / 320;
        const int ch = ln & 15, q = ln >> 4;
        unsigned short v[8];
#pragma unroll
        for (int jj = 0; jj < 8; ++jj) {
            if (kb < 4) { const int p = 16 * kb + 4 * q + (jj & 3); const size_t ci = ((size_t)g * 16 + ch) * 64 + p; v[jj] = (unsigned short)f2bf(jj < 4 ? P->in[9][ci] : -P->in[10][ci]); }
            else { const int c2 = 4 * q + (jj & 3); const float dv = P->in[11][g * 16 + ch]; const unsigned hi = f2bf(dv); const float lo = dv - __uint_as_float(hi << 16);
                   v[jj] = (c2 == ch) ? (unsigned short)(jj < 4 ? hi : f2bf(lo)) : (unsigned short)0; }
        }
        ((u32x4*)(ws + WS_CFRAG))[i] = (u32x4){(unsigned)v[0] | ((unsigned)v[1] << 16), (unsigned)v[2] | ((unsigned)v[3] << 16), (unsigned)v[4] | ((unsigned)v[5] << 16), (unsigned)v[6] | ((unsigned)v[7] << 16)};
    }
    for (size_t i = gt; i < (size_t)M * D / 8; i += NGT) {
        const size_t e = i * 8; const float* src = e < (size_t)MP * D ? P->in[0] + e : P->in[1] + (e - (size_t)MP * D);
        const f32x4 a = *(const f32x4*)src, b = *(const f32x4*)(src + 4);
        u32x4 w; w.x = cvt_pk_bf16(a[0], a[1]); w.y = cvt_pk_bf16(a[2], a[3]); w.z = cvt_pk_bf16(b[0], b[1]); w.w = cvt_pk_bf16(b[2], b[3]);
        ((u32x4*)(ws + WS_XB))[i] = w;
    }
}

constexpr int VROW = 144;
constexpr int ATT_ML = 131072;
struct AttBuf { bf16x8 kf[2][2]; u32x4 vreg[4]; };
__device__ __forceinline__ unsigned att_po(int t) { return (unsigned)((t >> 6) * 16384 + 8192 + (t & 63) * 128); }
template <int TYPE> __device__ __forceinline__ void att_step_params(int s, int i0, int t0, int& sh, int& mb) {
    if (TYPE == 0) { sh = s >= 5 ? 2 : 4; mb = s >= 5 ? (4 * i0 - 64 + 32 * (s - 5)) : (i0 - 64 + 32 * s); }
    else { sh = 0; mb = t0 - 64 + 32 * s; }
}
__device__ __forceinline__ void att_load(AttBuf& B, const bf16_t* __restrict__ Kt, const bf16_t* __restrict__ Vt, int sh, int mb, int r, int S, int sbrow, int h, int lane) {
    const int qi = lane & 15, g4 = lane >> 4;
    const int tlo = r + (mb << sh), thi = r + ((mb + 31) << sh);
    if (tlo >= 0 && thi < S) {
        const size_t ub = ((size_t)(sbrow + tlo) * DH + h * 64) * 2;
        const char* kb = (const char*)Kt + ub; const char* vb = (const char*)Vt + ub;
        const unsigned lk = (unsigned)(((qi << sh) * DH + 8 * g4) * 2), lv = (unsigned)((((lane >> 3) << sh) * DH + 8 * (lane & 7)) * 2);
        const unsigned bstep = (unsigned)((16 << sh) * DH * 2), vstep = (unsigned)((8 << sh) * DH * 2);
#pragma unroll
        for (int blk = 0; blk < 2; ++blk) { B.kf[blk][0] = *(const bf16x8*)(kb + blk * bstep + lk); B.kf[blk][1] = *(const bf16x8*)(kb + blk * bstep + lk + 64); }
#pragma unroll
        for (int i = 0; i < 4; ++i) B.vreg[i] = *(const u32x4*)(vb + i * vstep + lv);
    } else {
#pragma unroll
        for (int blk = 0; blk < 2; ++blk) {
            int tok = r + ((mb + 16 * blk + qi) << sh); tok = tok < 0 ? 0 : (tok >= S ? S - 1 : tok);
            const bf16_t* kp = Kt + (size_t)(sbrow + tok) * DH + h * 64 + 8 * g4;
            B.kf[blk][0] = *(const bf16x8*)kp; B.kf[blk][1] = *(const bf16x8*)(kp + 32);
        }
#pragma unroll
        for (int i = 0; i < 4; ++i) { const int idx = lane + 64 * i, rw = idx >> 3, ch = idx & 7;
            int tok = r + ((mb + rw) << sh); tok = tok < 0 ? 0 : (tok >= S ? S - 1 : tok);
            B.vreg[i] = *(const u32x4*)(Vt + (size_t)(sbrow + tok) * DH + h * 64 + 8 * ch); }
    }
}
__device__ __forceinline__ void att_comp(const AttBuf& B, const bf16x8 (&qf0)[2], f32x4 (&O)[2][4], float (&mrun)[2], float (&lsum)[2], LAS unsigned char* vl, unsigned vrd,
                                         int sh, int mb, int r, int S, int qp0, int qstep, int lane) {
    const int qi = lane & 15, g4 = lane >> 4;
    const float SC = 0.125f * 1.4426950408889634f;
#pragma unroll
    for (int i = 0; i < 4; ++i) { const int idx = lane + 64 * i, rw = idx >> 3, ch = idx & 7; *(LAS u32x4*)(vl + rw * VROW + ch * 16) = B.vreg[i]; }
    const int tlo = r + (mb << sh), thi = r + ((mb + 31) << sh);
    const bool edge = (tlo < 0) || (thi >= S);
    bf16x8 pf[2];
#pragma unroll
    for (int gq = 0; gq < 2; ++gq) {
        const int qg0 = qp0 + 16 * gq * qstep;
        if ((mb > qg0 + 15 * qstep + 64) || (mb + 31 < qg0 - 64)) { pf[gq] = (bf16x8){0, 0, 0, 0, 0, 0, 0, 0}; continue; }
        f32x4 sa[2];
        bf16x8 q0 = qf0[0], q1 = qf0[1];
        if (gq == 1) { q0 = *(const LAS bf16x8*)(vl + 4608 + lane * 16); q1 = *(const LAS bf16x8*)(vl + 4608 + 1024 + lane * 16); }
#pragma unroll
        for (int blk = 0; blk < 2; ++blk) {
            sa[blk] = __builtin_amdgcn_mfma_f32_16x16x32_bf16(B.kf[blk][0], q0, (f32x4){0.f, 0.f, 0.f, 0.f}, 0, 0, 0);
            sa[blk] = __builtin_amdgcn_mfma_f32_16x16x32_bf16(B.kf[blk][1], q1, sa[blk], 0, 0, 0);
        }
        const bool band = (mb < qg0 + 15 * qstep - 64) || (mb + 31 > qg0 + 64);
        float sv[8]; float mx;
        if (edge || band) {
            const int dbase = mb + 4 * g4 - (qg0 + qi * qstep) + 64;
            mx = -INFINITY;
#pragma unroll
            for (int blk = 0; blk < 2; ++blk)
#pragma unroll
                for (int j = 0; j < 4; ++j) {
                    bool ok = (unsigned)(dbase + 16 * blk + j) <= 128u;
                    if (edge) { const int tk = r + ((mb + 16 * blk + 4 * g4 + j) << sh); ok = ok && (tk >= 0) && (tk < S); }
                    const float x = ok ? sa[blk][j] : -INFINITY;
                    sv[blk * 4 + j] = x; mx = fmaxf(mx, x);
                }
        } else {
#pragma unroll
            for (int e = 0; e < 8; ++e) sv[e] = sa[e >> 2][e & 3];
            mx = fmaxf(fmaxf(fmaxf(sv[0], sv[1]), fmaxf(sv[2], sv[3])), fmaxf(fmaxf(sv[4], sv[5]), fmaxf(sv[6], sv[7])));
        }
        mx = fmaxf(mx, __shfl_xor(mx, 16)); mx = fmaxf(mx, __shfl_xor(mx, 32));
        const float mnew = fmaxf(mrun[gq], mx * SC);
        if (__builtin_amdgcn_ballot_w64(mnew > mrun[gq]) != 0ull) {
            const float alpha = fast_exp2(mrun[gq] - mnew);
            lsum[gq] *= alpha;
#pragma unroll
            for (int db = 0; db < 4; ++db) O[gq][db] *= alpha;
            mrun[gq] = mnew;
        }
        float p[8]; float ps = 0.f;
#pragma unroll
        for (int e = 0; e < 8; ++e) { p[e] = fast_exp2(sv[e] * SC - mrun[gq]); ps += p[e]; }
        lsum[gq] += ps;
        const u32x4 w = (u32x4){cvt_pk_bf16(p[0], p[1]), cvt_pk_bf16(p[2], p[3]), cvt_pk_bf16(p[4], p[5]), cvt_pk_bf16(p[6], p[7])}; pf[gq] = __builtin_bit_cast(bf16x8, w);
    }
#pragma unroll
    for (int db = 0; db < 4; ++db) {
        typedef short v4i16_t __attribute__((ext_vector_type(4)));
        const v4i16_t lo = __builtin_amdgcn_ds_read_tr16_b64_v4i16((LAS v4i16_t*)(vl + vrd + db * 32));
        const v4i16_t hi = __builtin_amdgcn_ds_read_tr16_b64_v4i16((LAS v4i16_t*)(vl + vrd + 16 * VROW + db * 32));
        const bf16x8 vf = (bf16x8){lo[0], lo[1], lo[2], lo[3], hi[0], hi[1], hi[2], hi[3]};
        O[0][db] = __builtin_amdgcn_mfma_f32_16x16x32_bf16(vf, pf[0], O[0][db], 0, 0, 0);
        O[1][db] = __builtin_amdgcn_mfma_f32_16x16x32_bf16(vf, pf[1], O[1][db], 0, 0, 0);
    }
}
template <int TYPE>
__device__ __forceinline__ void attn_tile(const bf16_t* __restrict__ Q, const bf16_t* __restrict__ Kt, const bf16_t* __restrict__ Vt, bf16_t* mix, float* ssq_a,
                                          LAS unsigned char* lds, LAS unsigned char* vl, int bb, int h, int idx, int lane) {
    constexpr int NS = TYPE == 0 ? 13 : 5;
    const int row0 = bb * 512;
    const int pos0 = row_pos(row0), S = row_slen(row0), sbrow = row0 - pos0;
    const int i0 = pos0 >> 4, t0 = pos0 + 32 * idx;
    const int qi = lane & 15, g4 = lane >> 4;
    const int r = TYPE == 0 ? idx : 0;
    int tq[2];
    bf16x8 qf[2];
#pragma unroll
    for (int gq = 0; gq < 2; ++gq) {
        tq[gq] = TYPE == 0 ? idx + 16 * (i0 + qi + 16 * gq) : t0 + qi + 16 * gq;
#pragma unroll
        for (int kk = 0; kk < 2; ++kk) { const bf16x8 qv = *(const bf16x8*)(Q + (size_t)(sbrow + tq[gq]) * DH + h * 64 + 32 * kk + 8 * g4);
            if (gq == 0) qf[kk] = qv; else *(LAS bf16x8*)(vl + 4608 + kk * 1024 + lane * 16) = qv; }
    }
    f32x4 O[2][4];
#pragma unroll
    for (int gq = 0; gq < 2; ++gq)
#pragma unroll
        for (int db = 0; db < 4; ++db) O[gq][db] = (f32x4){0.f, 0.f, 0.f, 0.f};
    float mrun[2] = {-1e30f, -1e30f}, lsum[2] = {0.f, 0.f};
    const unsigned vrd = (unsigned)((4 * g4 + ((lane & 15) >> 2)) * VROW + (lane & 3) * 8);
    AttBuf B0, B1, B2;
#define ATT_LOAD(B, s) do { int sh_, mb_; att_step_params<TYPE>((s), i0, t0, sh_, mb_); att_load(B, Kt, Vt, sh_, mb_, r, S, sbrow, h, lane); } while (0)
#define ATT_COMP(B, s) do { int sh_, mb_; att_step_params<TYPE>((s), i0, t0, sh_, mb_); \
        const int qstep_ = TYPE == 0 ? (16 >> sh_) : 1, qp0_ = TYPE == 0 ? qstep_ * i0 : t0; \
        att_comp(B, qf, O, mrun, lsum, vl, vrd, sh_, mb_, r, S, qp0_, qstep_, lane); } while (0)
    ATT_LOAD(B0, 0); ATT_LOAD(B1, 1);
    int s = 0;
#pragma unroll 1
    for (; s + 3 <= NS; s += 3) {
        if (s + 2 < NS) ATT_LOAD(B2, s + 2);
        ATT_COMP(B0, s);
        if (s + 3 < NS) ATT_LOAD(B0, s + 3);
        ATT_COMP(B1, s + 1);
        if (s + 4 < NS) ATT_LOAD(B1, s + 4);
        ATT_COMP(B2, s + 2);
    }
    if (NS % 3 >= 1) ATT_COMP(B0, s);
    if (NS % 3 >= 2) ATT_COMP(B1, s + 1);
#undef ATT_LOAD
#undef ATT_COMP
#pragma unroll
    for (int gq = 0; gq < 2; ++gq) {
        float ls = lsum[gq]; ls += __shfl_xor(ls, 16); ls += __shfl_xor(ls, 32);
        const int tb = tq[gq] - pos0;
        const unsigned po = att_po(tb), swz = (unsigned)((tb ^ (tb >> 4)) & 15);
        if (TYPE == 1) {
#pragma unroll
            for (int db = 0; db < 4; ++db) *(LAS u32x2*)(lds + po + (((unsigned)(4 * db + g4) ^ swz) << 3)) = (u32x2){cvt_pk_bf16(O[gq][db][0], O[gq][db][1]), cvt_pk_bf16(O[gq][db][2], O[gq][db][3])};
            if (g4 == 0) *(LAS f32x2*)(lds + ATT_ML + tb * 8) = (f32x2){mrun[gq], ls};
        } else {
            const f32x2 ml = *(const LAS f32x2*)(lds + ATT_ML + tb * 8);
            const float mm = fmaxf(mrun[gq], ml.x), ca = fast_exp2(mrun[gq] - mm), cb = fast_exp2(ml.x - mm);
            const float inv = 1.0f / (ls * ca + ml.y * cb);
            const float fa = ca * inv, fb = cb * inv;
            float ss = 0.f;
            bf16_t* orow = mix + (size_t)(sbrow + tq[gq]) * D + h * 64 + 4 * g4;
#pragma unroll
            for (int db = 0; db < 4; ++db) {
                const u32x2 obw = *(const LAS u32x2*)(lds + po + (((unsigned)(4 * db + g4) ^ swz) << 3));
                const f32x4 ob = (f32x4){bf_lo(obw.x), bf_hi(obw.x), bf_lo(obw.y), bf_hi(obw.y)};
                const f32x4 o = O[gq][db] * fa + ob * fb;
                ss += o[0] * o[0] + o[1] * o[1] + o[2] * o[2] + o[3] * o[3];
                *(u32x2*)(orow + 16 * db) = (u32x2){cvt_pk_bf16(o[0], o[1]), cvt_pk_bf16(o[2], o[3])};
            }
            ss += __shfl_xor(ss, 16); ss += __shfl_xor(ss, 32);
            if (g4 == 0) atomicAdd(ssq_a + sbrow + tq[gq], ss);
        }
    }
}

struct SsmPre { u32x2 ub[4]; float yf[4][4]; };
template <int MODE>
__device__ __forceinline__ void ssm_load(SsmPre& R, const bf16_t* __restrict__ U, const float* __restrict__ YF, unsigned uo, unsigned yo, int t0, int dir) {
    asm volatile("" : "+v"(uo), "+v"(yo));
#pragma unroll
    for (int k = 0; k < 4; ++k) {
        const unsigned tt = dir ? CL - 1 - (t0 + k) : t0 + k;
        R.ub[k] = *(const u32x2*)(U + (uo + tt * DH));
        if (MODE == 2) {
#pragma unroll
            for (int j = 0; j < 4; ++j) R.yf[k][j] = YF[yo + (j * CL + tt) * DH];
        }
    }
}
template <int MODE>
__device__ __forceinline__ void ssm_task(KP P, LAS unsigned char* lw, int sbk, int g, int dir, int lane) {
    unsigned char* ws = P->ws;
    const int c = lane & 15, q = lane >> 4, dg = dir * 32 + g;
    const bf16_t* U = (const bf16_t*)(ws + WS_U);
    float* YF = (float*)(ws + WS_YF);
    f32x2* ST = (f32x2*)(ws + WS_ST);
#pragma unroll
    for (int T = 0; T < 8; ++T) *(LAS u32x4*)(lw + T * 1024 + lane * 16) = ((const u32x4*)(ws + WS_BFRAG))[(dg * 8 + T) * 64 + lane];
    f32x4 lr[4], li[4], hr[4], hi[4];
#pragma unroll
    for (int s = 0; s < 4; ++s)
#pragma unroll
        for (int j = 0; j < 4; ++j) { const f32x2 l = ((const f32x2*)(ws + WS_LAM))[dg * 64 + 16 * s + 4 * q + j]; lr[s][j] = l.x; li[s][j] = l.y; hr[s][j] = 0.f; hi[s][j] = 0.f; }
    const int chunk = sbk * 16 + c;
    const size_t stbase = ((size_t)dg * NCHUNK + chunk) * 64;
    if (MODE != 0) {
#pragma unroll
        for (int s = 0; s < 4; ++s)
#pragma unroll
            for (int j = 0; j < 4; ++j) { const f32x2 v = ST[stbase + 16 * s + 4 * q + j]; hr[s][j] = v.x; hi[s][j] = v.y; }
    }
    if (MODE != 0) {
#pragma unroll
        for (int kb = 0; kb < 5; ++kb) *(LAS u32x4*)(lw + 8192 + kb * 1024 + lane * 16) = ((const u32x4*)(ws + WS_CFRAG))[(g * 5 + kb) * 64 + lane];
    }
#define BFR(T) (*(const LAS bf16x8*)(lw + (T) * 1024 + lane * 16))
#define CFR(kb) (*(const LAS bf16x8*)(lw + 8192 + (kb) * 1024 + lane * 16))
    unsigned uo = (unsigned)chunk * CL * DH + g * 16 + 4 * q;
    unsigned yo = (unsigned)(sbk * 16 + 4 * q) * CL * DH + g * 16 + c;
    SsmPre R0, R1;
#define SSM_STEP(R, k, t) do { \
        asm volatile("" : "+v"(yo) :: "memory"); \
        const bf16x8 ub = __builtin_bit_cast(bf16x8, ((u32x4){R.ub[k].x, R.ub[k].y, R.ub[k].x, R.ub[k].y})); \
        f32x4 bu[8]; \
        _Pragma("unroll") for (int T = 0; T < 8; ++T) bu[T] = __builtin_amdgcn_mfma_f32_16x16x32_bf16(BFR(T), ub, (f32x4){0.f, 0.f, 0.f, 0.f}, 0, 0, 0); \
        _Pragma("unroll") for (int s = 0; s < 4; ++s) { \
            const f32x4 nr = lr[s] * hr[s] - li[s] * hi[s] + bu[2 * s], ni = lr[s] * hi[s] + li[s] * hr[s] + bu[2 * s + 1]; \
            hr[s] = nr; hi[s] = ni; } \
        if (MODE != 0) { \
            f32x4 y = (f32x4){0.f, 0.f, 0.f, 0.f}; \
            if (MODE == 1) y = __builtin_amdgcn_mfma_f32_16x16x32_bf16(ub, CFR(4), y, 0, 0, 0); \
            _Pragma("unroll") for (int kb = 0; kb < 4; ++kb) { \
                const u32x4 w = (u32x4){cvt_pk_bf16(hr[kb][0], hr[kb][1]), cvt_pk_bf16(hr[kb][2], hr[kb][3]), cvt_pk_bf16(hi[kb][0], hi[kb][1]), cvt_pk_bf16(hi[kb][2], hi[kb][3])}; \
                y = __builtin_amdgcn_mfma_f32_16x16x32_bf16(__builtin_bit_cast(bf16x8, w), CFR(kb), y, 0, 0, 0); } \
            const unsigned tt = dir ? CL - 1 - (t) : (t); \
            _Pragma("unroll") for (int j = 0; j < 4; ++j) { \
                const unsigned oi = yo + (j * CL + tt) * DH; \
                if (MODE == 1) YF[oi] = y[j]; \
                else ((bf16_t*)(ws + WS_SPRE))[oi] = (bf16_t)(cvt_pk_bf16(gelu_tanh(y[j] + R.yf[k][j]), 0.f) & 0xffffu); } \
        } __builtin_amdgcn_sched_barrier(0); } while (0)
    SsmPre R2;
    ssm_load<MODE>(R0, U, YF, uo, yo, 0, dir);
    ssm_load<MODE>(R1, U, YF, uo, yo, 4, dir);
#define SSM_BLK(R, t0) do { SSM_STEP(R, 0, (t0)); SSM_STEP(R, 1, (t0) + 1); SSM_STEP(R, 2, (t0) + 2); SSM_STEP(R, 3, (t0) + 3); } while (0)
    ssm_load<MODE>(R2, U, YF, uo, yo, 8, dir);  SSM_BLK(R0, 0);
    ssm_load<MODE>(R0, U, YF, uo, yo, 12, dir); SSM_BLK(R1, 4);
    ssm_load<MODE>(R1, U, YF, uo, yo, 16, dir); SSM_BLK(R2, 8);
    ssm_load<MODE>(R2, U, YF, uo, yo, 20, dir); SSM_BLK(R0, 12);
    ssm_load<MODE>(R0, U, YF, uo, yo, 24, dir); SSM_BLK(R1, 16);
    ssm_load<MODE>(R1, U, YF, uo, yo, 28, dir); SSM_BLK(R2, 20);
    SSM_BLK(R0, 24);
    SSM_BLK(R1, 28);
#undef SSM_BLK
#undef SSM_STEP
#undef BFR
#undef CFR
    if (MODE == 0) {
#pragma unroll
        for (int s = 0; s < 4; ++s)
#pragma unroll
            for (int j = 0; j < 4; ++j) ST[stbase + 16 * s + 4 * q + j] = (f32x2){hr[s][j], hi[s][j]};
    }
}
__device__ __forceinline__ void ssm_carry(KP P, int gt, int NGT) {
    unsigned char* ws = P->ws; f32x2* ST = (f32x2*)(ws + WS_ST);
    for (int i = gt; i < 64 * 10 * 64; i += NGT) {
        const int p = i & 63, sq = (i >> 6) % 10, dg = i / 640, dir = dg >> 5;
        const int c0 = (sq < 2 ? sq * 16384 : MP + (sq - 2) * 8192) / CL, nc = (sq < 2 ? 16384 : 8192) / CL;
        const f32x2 L = ((const f32x2*)(ws + WS_LAML))[dg * 64 + p];
        f32x2 carry = (f32x2){0.f, 0.f};
        f32x2* base = ST + ((size_t)dg * NCHUNK + c0) * 64 + p;
        for (int k0 = 0; k0 < nc; k0 += 32) {
            f32x2 e[32];
#pragma unroll
            for (int k = 0; k < 32; ++k) { const int ck = dir ? nc - 1 - (k0 + k) : k0 + k; e[k] = base[(size_t)ck * 64]; }
#pragma unroll
            for (int k = 0; k < 32; ++k) { const int ck = dir ? nc - 1 - (k0 + k) : k0 + k; base[(size_t)ck * 64] = carry;
                const float cr = L.x * carry.x - L.y * carry.y + e[k].x, ci = L.x * carry.y + L.y * carry.x + e[k].y; carry = (f32x2){cr, ci}; }
        }
    }
}

constexpr int LDS_BYTES = 147456;
__global__ void __launch_bounds__(512, 2) mega_fwd(Params Pval, int ph_lo, int ph_hi) {
    KP P = (KP)__builtin_amdgcn_kernarg_segment_ptr();
    extern __shared__ __attribute__((aligned(16))) unsigned char lds_raw[];
    LAS unsigned char* lds = (LAS unsigned char*)lds_raw;
    cg::grid_group grid = cg::this_grid();
    const int tid = threadIdx.x, lane = tid & 63, wave = __builtin_amdgcn_readfirstlane(tid >> 6);
    const int G = gridDim.x, bx = blockIdx.x;
    const int gw = bx * 8 + wave, NGW = G * 8;
    const int vgw = ((G & 7) == 0 ? (bx & 7) * (G >> 3) + (bx >> 3) : bx) * 8 + wave;
#define PHASE_VARS asm volatile("" : "+s"(P)); unsigned char* ws = P->ws; float* stats = (float*)(ws + WS_STATS); \
    float* ssq_a = stats, *ssq_s = stats + M, *ln1_sum = stats + 2 * M, *ln1_sq = stats + 3 * M, *ln2_sum = stats + 4 * M, *ln2_sq = stats + 5 * M; \
    (void)ssq_a; (void)ssq_s; (void)ln1_sum; (void)ln1_sq; (void)ln2_sum; (void)ln2_sq;
#ifndef PH_MASK
#define PH_MASK 0x7ff
#endif
#define IN(k) (((PH_MASK >> (k)) & 1) && ph_lo <= (k) && (k) < ph_hi)
#define SEAM(k) do { if (ph_lo <= (k) && (k) + 1 < ph_hi) grid.sync(); } while (0)
    if (IN(0)) { asm volatile("" : "+s"(P)); p0_prep(P, lds, gw, NGW, lane); }
    SEAM(0);
    if (IN(1)) {
        PHASE_VARS
        pg8::Gemm g{(const bf16_t*)(ws + WS_XB), (const bf16_t*)(ws + WS_WIN), D}; pg8::StaticOrder S; S.init(M / 256, NIN / 256, G, bx);
        EpiIn E{(bf16_t*)(ws + WS_Q), (const float*)(ws + WS_ROPEC), (const float*)(ws + WS_ROPES)};
        pg8::gemm_phase<EpiIn, 0>(lds, g, S, E);
    }
    SEAM(1);
    if (IN(2)) {
        PHASE_VARS
        for (int it = bx; it < (M / 512) * 8; it += G) {
            const int bb = it >> 3, h = it & 7;
            const bf16_t* Qp = (const bf16_t*)(ws + WS_Q); const bf16_t* Kp = (const bf16_t*)(ws + WS_K); const bf16_t* Vp = (const bf16_t*)(ws + WS_V);
            for (int j = wave; j < 16; j += 8) attn_tile<1>(Qp, Kp, Vp, (bf16_t*)(ws + WS_MIX), ssq_a, lds, lds + wave * 16384, bb, h, j, lane);
            __syncthreads();
            for (int r = wave; r < 16; r += 8) attn_tile<0>(Qp, Kp, Vp, (bf16_t*)(ws + WS_MIX), ssq_a, lds, lds + wave * 16384, bb, h, r, lane);
            __syncthreads();
        }
        for (int it = vgw; it < (M / (16 * CL)) * 64; it += NGW) ssm_task<0>(P, lds + wave * 16384, it >> 6, it & 31, (it >> 5) & 1, lane);
    }
    SEAM(2);
    if (IN(3)) { asm volatile("" : "+s"(P)); } if (IN(3)) ssm_carry(P, gw * 64 + lane, NGW * 64);
    SEAM(3);
    if (IN(4)) { asm volatile("" : "+s"(P)); for (int it = vgw; it < (M / (16 * CL)) * 32; it += NGW) ssm_task<1>(P, lds + wave * 16384, it >> 5, it & 31, 0, lane); }
    SEAM(4);
    if (IN(5)) { asm volatile("" : "+s"(P)); for (int it = vgw; it < (M / (16 * CL)) * 32; it += NGW) ssm_task<2>(P, lds + wave * 16384, it >> 5, it & 31, 1, lane); }
    SEAM(5);
    if (IN(6)) {
        PHASE_VARS
        pg8::Gemm g{(const bf16_t*)(ws + WS_SPRE), (const bf16_t*)(ws + WS_WGLU), DH}; pg8::StaticOrder S; S.init(M / 256, DH / 256, G, bx);
        EpiGlu E{(const bf16_t*)(ws + WS_SPRE), (bf16_t*)(ws + WS_MIX), P->in[13], ssq_s};
        pg8::gemm_phase<EpiGlu, 0>(lds, g, S, E);
    }
    SEAM(6);
    if (IN(7)) {
        PHASE_VARS
        pg8::Gemm g{(const bf16_t*)(ws + WS_MIX), (const bf16_t*)(ws + WS_WOUT), D}; pg8::StaticOrder S; S.init(M / 256, D / 256, G, bx);
        EpiOut E{P->in[0], P->in[1], P->out, (bf16_t*)(ws + WS_Y1B), ssq_a, ssq_s, ln1_sum, ln1_sq};
        pg8::gemm_phase<EpiOut, 0>(lds, g, S, E);
    }
    SEAM(7);
    if (IN(8)) {
        PHASE_VARS
        pg8::Gemm g{(const bf16_t*)(ws + WS_Y1B) - D, (const bf16_t*)(ws + WS_WUP), D}; pg8::StaticOrder S; S.init(UP_NM, NUP / 256, G, bx);
        EpiUp E{(bf16_t*)(ws + WS_F), (const float*)(ws + WS_GW), (const float*)(ws + WS_BW), P->in[19], P->in[20], ln1_sum, ln1_sq};
        pg8::gemm_phase<EpiUp, 1>(lds, g, S, E);
    }
    SEAM(8);
    if (IN(9)) {
        PHASE_VARS
        pg8::Gemm g{(const bf16_t*)(ws + WS_F), (const bf16_t*)(ws + WS_WDN), FF}; pg8::StaticOrder S; S.init(M / 256, D / 256, G, bx);
        EpiDown E{P->out, P->in[16], P->in[17], ln1_sum, ln1_sq, ln2_sum, ln2_sq};
        pg8::gemm_phase<EpiDown, 0>(lds, g, S, E);
    }
    SEAM(9);
    if (IN(10)) {
        PHASE_VARS
        const float* g2 = P->in[22]; const float* b2 = P->in[23];
        for (int row = gw; row < M; row += NGW) {
            const float mu = ln2_sum[row] * (1.0f / D), var = ln2_sq[row] * (1.0f / D) - mu * mu, rstd = __builtin_amdgcn_rsqf(var + LN_EPS);
            f32x4* p = (f32x4*)(P->out + (size_t)row * D) + lane;
#pragma unroll
            for (int j = 0; j < 4; ++j) { const f32x4 y = p[64 * j], gg = ((const f32x4*)g2)[64 * j + lane], bb = ((const f32x4*)b2)[64 * j + lane]; p[64 * j] = (y - mu) * rstd * gg + bb; }
        }
    }
#undef IN
#undef SEAM
}

extern "C" void kernel_launch(void* const* d_in, const int* in_sizes, int n_in, void* d_out, int out_size, void* d_ws, size_t ws_size, hipStream_t stream) {
    static int grid = 0;
    if (grid == 0) {
        if (n_in != 24 || ws_size < WS_END) { fprintf(stderr, "kernel_launch: unexpected n_in %d / ws_size %zu (need %zu)\n", n_in, ws_size, (size_t)WS_END); grid = -1; return; }
        int dev = 0, cus = 0, per_cu = 0;
        hipGetDevice(&dev); hipDeviceGetAttribute(&cus, hipDeviceAttributeMultiprocessorCount, dev);
        hipFuncSetAttribute((const void*)mega_fwd, hipFuncAttributeMaxDynamicSharedMemorySize, LDS_BYTES);
        hipOccupancyMaxActiveBlocksPerMultiprocessor(&per_cu, (const void*)mega_fwd, 512, LDS_BYTES);
        (void)hipGetLastError();
        if (per_cu < 1) per_cu = 1;
        grid = cus * per_cu;
    }
    if (grid < 0) return;
    Params p{};
    for (int i = 0; i < 24; ++i) p.in[i] = (const float*)d_in[i];
    p.out = (float*)d_out; p.ws = (unsigned char*)d_ws;
    int lo = 0, hi = 11;
    void* args[] = {&p, &lo, &hi};
    hipError_t e = hipLaunchCooperativeKernel((const void*)mega_fwd, dim3(grid), dim3(512), args, LDS_BYTES, stream);
    if (e != hipSuccess) fprintf(stderr, "cooperative launch failed: %s (grid %d)\n", hipGetErrorString(e), grid);
}
```

```cpp
#include <hip/hip_runtime.h>
#include <hip/hip_cooperative_groups.h>
#include <cstdio>
#include <cstdint>
namespace cg = cooperative_groups;

#define LAS __attribute__((address_space(3)))
typedef unsigned short bf16_t;
typedef short bf16x8 __attribute__((ext_vector_type(8)));
typedef short bf16x4 __attribute__((ext_vector_type(4)));
typedef float f32x4 __attribute__((ext_vector_type(4)));
typedef float f32x2 __attribute__((ext_vector_type(2)));
typedef f32x4 f32x4u __attribute__((aligned(4)));
typedef unsigned u32x4 __attribute__((ext_vector_type(4)));
typedef unsigned u32x2 __attribute__((ext_vector_type(2)));

constexpr int M = 98304, D = 1024, NIN = 2048, DH = 512, FF = 2816, NUP = 5632;
constexpr int MP = 32768;
constexpr int CL = 32;
constexpr int NCHUNK = M / CL;
constexpr float LN_EPS = 1e-5f;
constexpr float DN_ALPHA = 1.189207115002721f;
constexpr int UP_TM = 252;
constexpr int UP_NM = (M + UP_TM - 1) / UP_TM;

constexpr size_t MiB = 1u << 20;
constexpr size_t WS_STATS = 0;
constexpr size_t WS_ROPEC = 3 * MiB, WS_ROPES = WS_ROPEC + 16384 * 8 * 4;
constexpr size_t WS_LAM = 4 * MiB + 0;
constexpr size_t WS_LAML = WS_LAM + 32768;
constexpr size_t WS_BFRAG = WS_LAML + 32768;
constexpr size_t WS_CFRAG = WS_BFRAG + 524288;
constexpr size_t WS_GW = WS_CFRAG + 163840;
constexpr size_t WS_BW = WS_GW + 32768;
static_assert(WS_BW + 32768 <= 5 * MiB, "tables");
constexpr size_t WS_WIN = 5 * MiB;
constexpr size_t WS_WGLU = 9 * MiB;
constexpr size_t WS_WOUT = 10 * MiB;
constexpr size_t WS_WUP = 12 * MiB;
constexpr size_t WS_WDN = 24 * MiB;
constexpr size_t WS_A = 32 * MiB;
constexpr size_t WS_XB = WS_A, WS_Q = WS_A + 192 * MiB, WS_K = WS_Q + 96 * MiB, WS_V = WS_K + 96 * MiB, WS_U = WS_V + 96 * MiB;
constexpr size_t WS_YF = WS_XB;
constexpr size_t WS_SPRE = WS_Q;
constexpr size_t WS_F = WS_A;
constexpr size_t WS_MIX = WS_A + 576 * MiB;
constexpr size_t WS_Y1B = WS_MIX + 192 * MiB + 1 * MiB;
constexpr size_t WS_ST = WS_Y1B;
constexpr size_t WS_END = WS_Y1B + 192 * MiB + 1 * MiB;
static_assert(WS_END <= 1024 * MiB, "workspace map must fit 1 GiB");
static_assert(CL == 32, "the scan's prefetch ring is written out for 8 blocks of 4 steps");

__device__ __forceinline__ unsigned cvt_pk_bf16(float lo, float hi) { unsigned r; asm volatile("v_cvt_pk_bf16_f32 %0, %1, %2" : "=v"(r) : "v"(lo), "v"(hi)); return r; }
__device__ __forceinline__ float bf_lo(unsigned w) { return __uint_as_float(w << 16); }
__device__ __forceinline__ float bf_hi(unsigned w) { return __uint_as_float(w & 0xffff0000u); }
__device__ __forceinline__ float fast_exp2(float x) { return __builtin_amdgcn_exp2f(x); }
__device__ __forceinline__ float fast_rcp(float x) { return __builtin_amdgcn_rcpf(x); }
__device__ __forceinline__ float gelu_tanh(float x) {
    const float u = x * (1.0f + 0.044715f * x * x);
    const float e = fast_exp2(u * (-2.0f * 0.7978845608028654f * 1.4426950408889634f));
    return x * fast_rcp(1.0f + e);
}
__device__ __forceinline__ float sigmoidf_(float z) { return fast_rcp(1.0f + fast_exp2(-1.4426950408889634f * z)); }
__device__ __forceinline__ int row_pos(int row) { return row < MP ? (row & 16383) : (row & 8191); }
__device__ __forceinline__ int row_slen(int row) { return row < MP ? 16384 : 8192; }
template <int CTRL> __device__ __forceinline__ float dpp_f(float v) { return __int_as_float(__builtin_amdgcn_update_dpp(0, __float_as_int(v), CTRL, 0xF, 0xF, false)); }

struct Params {
    const float* in[24];
    float* out;
    unsigned char* ws;
};
typedef const __attribute__((address_space(4))) Params* KP;

namespace pg8 {
constexpr int BM = 256, BK = 64, HALF = 128, HTB = HALF * BK * 2, STAGE_BYTES = 8 * HTB, NXCD = 8, WGM = 8;
__device__ __forceinline__ int lds_byte(int r, int c) { const int st = (r >> 4) * 2 + (c >> 5), rr = r & 15, cc = c & 31, ob = rr * 64 + cc * 2; return st * 1024 + (ob ^ (((ob >> 9) & 1) << 5)); }
__device__ __forceinline__ void stage_rc(int b, int& R, int& C) { const int st = b / 1024, sb = b % 1024, swz = sb ^ (((sb >> 9) & 1) << 5); R = (st >> 1) * 16 + swz / 64; C = (st & 1) * 32 + (swz % 64) / 2; }
__device__ __forceinline__ int perm32(int rho) { const int n = rho >> 4, i = rho & 15; return 8 * (i >> 2) + 4 * n + (i & 3); }
struct Unit { int pm, pn; };
struct Gemm { const bf16_t* A; const bf16_t* Bt; int K; };
struct StaticOrder {
    int nM, nN, nwg, G, c;
    __device__ void init(int nM_, int nN_, int G_, int c_) { nM = nM_; nN = nN_; nwg = nM * nN; G = G_; c = c_; }
    __device__ bool next(int i, Unit& u) const {
        const long L = (long)i * G + c; if (L >= nwg) return false;
        int wgid = (int)L; { const int q = nwg / NXCD, r = nwg % NXCD, xcd = wgid % NXCD, off = wgid / NXCD; wgid = (xcd < r ? xcd * (q + 1) : r * (q + 1) + (xcd - r) * q) + off; }
        const int nig = WGM * nN, gid = wgid / nig, fm = gid * WGM, gsz = (nM - fm) < WGM ? (nM - fm) : WGM;
        u.pm = fm + ((wgid % nig) % gsz); u.pn = (wgid % nig) / gsz; return true;
    }
};

template <class Epi, int AMODE>
__device__ __forceinline__ void gemm_phase(LAS unsigned char* lds, const Gemm g, const StaticOrder& S, const Epi& E) {
    const int tid = threadIdx.x, wid = __builtin_amdgcn_readfirstlane(tid >> 6), lane = tid & 63, wr = wid >> 2, wc = wid & 3, fr = lane & 15, fq = lane >> 4;
    constexpr bool SPLIT2 = Epi::MID_T > 0;
    const int K = g.K, nt = SPLIT2 ? K / BK / 2 : K / BK;
    const size_t koff = (size_t)K;
    unsigned voffA[2], voffB[2];
#pragma unroll
    for (int i = 0; i < 2; ++i) { int R, C; stage_rc(tid * 16 + i * 8192, R, C); const int Rb = (R & ~31) + perm32(R & 31);
        const int Ra = AMODE == 1 ? (126 * (R >> 6) + 8 * (R & 15) + ((R >> 4) & 3)) : R;
        voffA[i] = AMODE == 2 ? (unsigned)(((C >> 4) * M + R) * 32 + (C & 15) * 2) : (unsigned)(Ra * K + C) * 2u; voffB[i] = (unsigned)(Rb * K + C) * 2u; }
    const size_t kstep = (size_t)(BK * 2);
    const size_t hstepB = (size_t)HALF * K * 2, tstepB = 2 * hstepB;
    const size_t hstepA = AMODE == 1 ? (size_t)4 * K * 2 : (AMODE == 2 ? (size_t)HALF * 32 : hstepB), tstepA = AMODE == 1 ? (size_t)UP_TM * K * 2 : (AMODE == 2 ? (size_t)BM * 32 : tstepB);
    const size_t kstepA = AMODE == 2 ? (size_t)4 * M * 32 : kstep;
    const unsigned ldsw = (unsigned)wid * 1024u;
    const int aoff = lds_byte(wr * 64 + fr, fq * 8), boff = lds_byte(wc * 32 + fr, fq * 8);
#define PG8_SA(b, h) (((b) * 2 + (h)) * HTB)
#define PG8_SB(b, h) ((4 + (b) * 2 + (h)) * HTB)
#define PG8_STAGE(bufoff, gbase, voff) do { _Pragma("unroll") for (int _i = 0; _i < 2; ++_i) \
        __builtin_amdgcn_global_load_lds((const unsigned*)((const char*)(gbase) + (voff)[_i]), (LAS unsigned*)(lds + (bufoff) + ldsw + _i * 8192), 16, 0, 0); } while (0)
#define PG8_LDA(dst, b, h) do { _Pragma("unroll") for (int m = 0; m < 4; ++m) _Pragma("unroll") for (int k = 0; k < 2; ++k) dst[m][k] = *(const LAS bf16x8*)(lds + PG8_SA(b, h) + aoff + m * 2048 + k * 1024); } while (0)
#define PG8_LDB(dst, b, h) do { _Pragma("unroll") for (int n = 0; n < 2; ++n) _Pragma("unroll") for (int k = 0; k < 2; ++k) dst[n][k] = *(const LAS bf16x8*)(lds + PG8_SB(b, h) + boff + n * 2048 + k * 1024); } while (0)
#define PG8_MMA(ai, bj, At, Bt) do { __builtin_amdgcn_s_setprio(1); _Pragma("unroll") for (int m = 0; m < 4; ++m) _Pragma("unroll") for (int n = 0; n < 2; ++n) _Pragma("unroll") for (int k = 0; k < 2; ++k) \
        acc[ai][bj][m][n] = __builtin_amdgcn_mfma_f32_16x16x32_bf16(Bt[n][k], At[m][k], acc[ai][bj][m][n], 0, 0, 0); __builtin_amdgcn_s_setprio(0); } while (0)
#define PG8_WAIT_V(n) asm volatile("s_waitcnt vmcnt(" #n ")" ::: "memory")
#define PG8_WAIT_L(n) asm volatile("s_waitcnt lgkmcnt(" #n ")" ::: "memory")
#define PG8_BAR __builtin_amdgcn_s_barrier()
#define PG8_SCHED __builtin_amdgcn_sched_barrier(0)
    Unit cur, nxt; int ui = 0;
    if (!S.next(0, cur)) return;
#define PG8_HALF(i) (SPLIT2 ? ((i) & 1) : 0)
#define PG8_NEXT(i, u) (SPLIT2 ? S.next((i) >> 1, u) : S.next((i), u))
    f32x4 acc[2][2][4][2];
#pragma unroll
    for (int a = 0; a < 2; ++a)
#pragma unroll
        for (int b = 0; b < 2; ++b)
#pragma unroll
            for (int m = 0; m < 4; ++m)
#pragma unroll
                for (int n = 0; n < 2; ++n) acc[a][b][m][n] = (f32x4){0.f, 0.f, 0.f, 0.f};
    bf16x8 At[4][2], B0[2][2], B1[2][2];
    const char* cA = (const char*)g.A + (size_t)cur.pm * tstepA; const char* cB = (const char*)g.Bt + (size_t)cur.pn * tstepB;
    PG8_STAGE(PG8_SB(0, 0), cB, voffB); PG8_STAGE(PG8_SB(0, 1), cB + hstepB, voffB); PG8_STAGE(PG8_SA(0, 0), cA, voffA); PG8_STAGE(PG8_SA(0, 1), cA + hstepA, voffA);
    if (wr == 1) PG8_BAR;
    PG8_WAIT_V(2); PG8_BAR;
    PG8_STAGE(PG8_SB(1, 0), cB + kstep, voffB); PG8_STAGE(PG8_SA(1, 0), cA + kstepA, voffA); PG8_STAGE(PG8_SB(1, 1), cB + hstepB + kstep, voffB);
    PG8_WAIT_V(6); PG8_BAR;
    for (;;) {
        const bool has_next = PG8_NEXT(ui + 1, nxt);
        const char* nA = has_next ? (const char*)g.A + (size_t)nxt.pm * tstepA + PG8_HALF(ui + 1) * koff : cA; const char* nB = has_next ? (const char*)g.Bt + (size_t)nxt.pn * tstepB + PG8_HALF(ui + 1) * koff : cB;
        for (int t = 0; t < nt; t += 2) {
            const bool last = (t == nt - 2);
            const char* a1 = cA + (size_t)(t + 1) * kstepA;
            const char* a2 = last ? nA : cA + (size_t)(t + 2) * kstepA; const char* b2 = last ? nB : cB + (size_t)(t + 2) * kstep;
            const char* a3 = a2 + kstepA; const char* b3 = b2 + kstep;
            PG8_LDB(B0, 0, 0); PG8_LDB(B1, 0, 1); PG8_SCHED; PG8_LDA(At, 0, 0); PG8_STAGE(PG8_SA(1, 1), a1 + hstepA, voffA);
            PG8_WAIT_V(8); PG8_WAIT_L(0); PG8_BAR; PG8_MMA(0, 0, At, B0); PG8_MMA(0, 1, At, B1); PG8_BAR; PG8_SCHED;
            PG8_LDA(At, 0, 1); PG8_STAGE(PG8_SB(0, 0), b2, voffB); PG8_STAGE(PG8_SB(0, 1), b2 + hstepB, voffB); PG8_STAGE(PG8_SA(0, 0), a2, voffA);
            PG8_WAIT_V(8); PG8_WAIT_L(0); PG8_BAR; PG8_MMA(1, 0, At, B0); PG8_MMA(1, 1, At, B1); PG8_BAR; PG8_SCHED;
            PG8_LDB(B0, 1, 0); PG8_LDB(B1, 1, 1); PG8_SCHED; PG8_LDA(At, 1, 0); PG8_STAGE(PG8_SA(0, 1), a2 + hstepA, voffA);
            PG8_WAIT_V(8); PG8_WAIT_L(0); PG8_BAR; PG8_MMA(0, 0, At, B0); PG8_MMA(0, 1, At, B1); PG8_BAR; PG8_SCHED;
            PG8_LDA(At, 1, 1); PG8_STAGE(PG8_SB(1, 0), b3, voffB); PG8_STAGE(PG8_SB(1, 1), b3 + hstepB, voffB); PG8_STAGE(PG8_SA(1, 0), a3, voffA);
            PG8_WAIT_V(8); PG8_WAIT_L(0); PG8_BAR; PG8_MMA(1, 0, At, B0); PG8_MMA(1, 1, At, B1); PG8_BAR; PG8_SCHED;
        }
        if (wr == 0) PG8_BAR;
        if constexpr (SPLIT2) {
            const bool fin = PG8_HALF(ui) == 1;
            if (fin) E(acc, cur, wr, wc, fr, fq);
            if (fin && !has_next) break;
            float fs[8]; E.scales(fs, cur, fin, wr, fr);
#pragma unroll
            for (int a = 0; a < 2; ++a)
#pragma unroll
                for (int b = 0; b < 2; ++b)
#pragma unroll
                    for (int m = 0; m < 4; ++m)
#pragma unroll
                        for (int n = 0; n < 2; ++n) acc[a][b][m][n] *= fs[a * 4 + m];
        } else {
        E(acc, cur, wr, wc, fr, fq);
        if (!has_next) break;
#pragma unroll
        for (int a = 0; a < 2; ++a)
#pragma unroll
            for (int b = 0; b < 2; ++b)
#pragma unroll
                for (int m = 0; m < 4; ++m)
#pragma unroll
                    for (int n = 0; n < 2; ++n) acc[a][b][m][n] = (f32x4){0.f, 0.f, 0.f, 0.f};
        }
        cur = nxt; cA = nA; cB = nB; ++ui;
        if (wr == 1) PG8_BAR;
    }
    PG8_WAIT_V(0);
    PG8_BAR;
#undef PG8_HALF
#undef PG8_NEXT
#undef PG8_SA
#undef PG8_SB
#undef PG8_STAGE
#undef PG8_LDA
#undef PG8_LDB
#undef PG8_MMA
#undef PG8_WAIT_V
#undef PG8_WAIT_L
#undef PG8_BAR
#undef PG8_SCHED
}
}
using pg8::Unit;
typedef f32x4 AccT[2][2][4][2];

struct EpiIn {
    static constexpr int MID_T = 0;
    bf16_t* qkvu; const float* ropec; const float* ropes;
    __device__ __forceinline__ void operator()(const AccT& acc, const Unit& u, int wr, int wc, int fr, int fq) const {
        const int t = u.pn >> 1;
        bf16_t* base = qkvu + (size_t)t * M * DH;
        const int col0 = (u.pn & 1) * 256 + wc * 32 + 8 * fq;
        const bool rope = (t < 2) && ((wc & 1) == 0);
#pragma unroll
        for (int ai = 0; ai < 2; ++ai)
#pragma unroll
            for (int m = 0; m < 4; ++m) {
                const int row = u.pm * 256 + ai * 128 + wr * 64 + m * 16 + fr;
                f32x4 v[2][2];
#pragma unroll
                for (int bj = 0; bj < 2; ++bj)
#pragma unroll
                    for (int n = 0; n < 2; ++n) v[bj][n] = acc[ai][bj][m][n];
                if (rope) {
                    const int pos = row_pos(row);
#pragma unroll
                    for (int n = 0; n < 2; ++n) {
                        const f32x4 c4 = *(const f32x4*)(ropec + pos * 8 + 4 * n), s4 = *(const f32x4*)(ropes + pos * 8 + 4 * n);
#pragma unroll
                        for (int bj = 0; bj < 2; ++bj) {
                            f32x4 o;
#pragma unroll
                            for (int e = 0; e < 4; ++e) o[e] = __shfl_xor(v[bj][n][e], 16);
                            const f32x4 r0 = v[bj][n] * c4 - o * s4, r1 = v[bj][n] * c4 + o * s4;
                            if (fq == 0) v[bj][n] = r0; else if (fq == 1) v[bj][n] = r1;
                        }
                    }
                }
#pragma unroll
                for (int bj = 0; bj < 2; ++bj) {
                    u32x4 w; w.x = cvt_pk_bf16(v[bj][0][0], v[bj][0][1]); w.y = cvt_pk_bf16(v[bj][0][2], v[bj][0][3]); w.z = cvt_pk_bf16(v[bj][1][0], v[bj][1][1]); w.w = cvt_pk_bf16(v[bj][1][2], v[bj][1][3]);
                    const int col = col0 + bj * 128;
                    if (t == 3) *(u32x4*)(base + ((size_t)(col >> 4) * M + row) * 16 + (col & 15)) = w;
                    else *(u32x4*)(base + (size_t)row * DH + col) = w;
                }
            }
    }
};
struct EpiGlu {
    static constexpr int MID_T = 0;
    const bf16_t* spre; bf16_t* mix; const float* bglu; float* ssq_s;
    __device__ __forceinline__ void operator()(const AccT& acc, const Unit& u, int wr, int wc, int fr, int fq) const {
        const int col0 = u.pn * 256 + wc * 32 + 8 * fq;
#pragma unroll
        for (int ai = 0; ai < 2; ++ai)
#pragma unroll
            for (int m = 0; m < 4; ++m) {
                const int row = u.pm * 256 + ai * 128 + wr * 64 + m * 16 + fr; float ss = 0.f;
#pragma unroll
                for (int bj = 0; bj < 2; ++bj) {
                    const int col = col0 + bj * 128;
                    const u32x4 sv = *(const u32x4*)(spre + ((size_t)(col >> 4) * M + row) * 16 + (col & 15));
                    const f32x4 b0 = *(const f32x4*)(bglu + col), b1 = *(const f32x4*)(bglu + col + 4);
                    const f32x4 z0 = acc[ai][bj][m][0] + b0, z1 = acc[ai][bj][m][1] + b1;
                    float o[8];
                    o[0] = bf_lo(sv.x) * sigmoidf_(z0[0]); o[1] = bf_hi(sv.x) * sigmoidf_(z0[1]); o[2] = bf_lo(sv.y) * sigmoidf_(z0[2]); o[3] = bf_hi(sv.y) * sigmoidf_(z0[3]);
                    o[4] = bf_lo(sv.z) * sigmoidf_(z1[0]); o[5] = bf_hi(sv.z) * sigmoidf_(z1[1]); o[6] = bf_lo(sv.w) * sigmoidf_(z1[2]); o[7] = bf_hi(sv.w) * sigmoidf_(z1[3]);
#pragma unroll
                    for (int e = 0; e < 8; ++e) ss += o[e] * o[e];
                    u32x4 w; w.x = cvt_pk_bf16(o[0], o[1]); w.y = cvt_pk_bf16(o[2], o[3]); w.z = cvt_pk_bf16(o[4], o[5]); w.w = cvt_pk_bf16(o[6], o[7]);
                    *(u32x4*)(mix + (size_t)row * D + DH + col) = w;
                }
                ss += __shfl_xor(ss, 16); ss += __shfl_xor(ss, 32);
                if (fq == 0) atomicAdd(ssq_s + row, ss);
                asm volatile("" ::: "memory");
            }
    }
};
struct EpiOut {
    static constexpr int MID_T = 8;
    const float* xp; const float* xs; float* out; bf16_t* y1b; const float* ssq_a; const float* ssq_s; float* ln_sum; float* ln_sq;
    __device__ __forceinline__ void scales(float (&fs)[8], const Unit& u, bool fin, int wr, int fr) const {
#pragma unroll
        for (int i = 0; i < 8; ++i) {
            const int row = u.pm * 256 + (i >> 2) * 128 + wr * 64 + (i & 3) * 16 + fr;
            const float va = ssq_a[row] * (1.0f / DH) + LN_EPS, vs = ssq_s[row] * (1.0f / DH) + LN_EPS;
            const float f = __builtin_amdgcn_sqrtf(vs * fast_rcp(va));
            fs[i] = fin ? 0.f : f;
        }
    }
    __device__ __forceinline__ void operator()(const AccT& acc, const Unit& u, int wr, int wc, int fr, int fq) const {
        const int col0 = u.pn * 256 + wc * 32 + 8 * fq;
        const float* xb = (u.pm < MP / 256) ? xp : xs - (size_t)MP * D;
#pragma unroll
        for (int ai = 0; ai < 2; ++ai)
#pragma unroll
            for (int m = 0; m < 4; ++m) {
                const int row = u.pm * 256 + ai * 128 + wr * 64 + m * 16 + fr;
                const float rs = __builtin_amdgcn_rsqf(ssq_s[row] * (1.0f / DH) + LN_EPS);
                const size_t ro = (size_t)row * D + col0;
                float s1 = 0.f, s2 = 0.f;
#pragma unroll
                for (int bj = 0; bj < 2; ++bj) {
                    const size_t o = ro + bj * 128;
                    const f32x4 x0 = *(const f32x4*)(xb + o), x1 = *(const f32x4*)(xb + o + 4);
                    const f32x4 y0 = x0 * DN_ALPHA + acc[ai][bj][m][0] * rs, y1 = x1 * DN_ALPHA + acc[ai][bj][m][1] * rs;
                    s1 += ((y0[0] + y0[1]) + (y0[2] + y0[3])) + ((y1[0] + y1[1]) + (y1[2] + y1[3]));
                    s2 += ((y0[0] * y0[0] + y0[1] * y0[1]) + (y0[2] * y0[2] + y0[3] * y0[3])) + ((y1[0] * y1[0] + y1[1] * y1[1]) + (y1[2] * y1[2] + y1[3] * y1[3]));
                    *(u32x4*)(y1b + o) = (u32x4){cvt_pk_bf16(y0[0], y0[1]), cvt_pk_bf16(y0[2], y0[3]), cvt_pk_bf16(y1[0], y1[1]), cvt_pk_bf16(y1[2], y1[3])};
                }
                s1 += __shfl_xor(s1, 16); s1 += __shfl_xor(s1, 32); s2 += __shfl_xor(s2, 16); s2 += __shfl_xor(s2, 32);
                if (fq == 0) { atomicAdd(ln_sum + row, s1); atomicAdd(ln_sq + row, s2); }
                asm volatile("" ::: "memory");
            }
    }
};
struct EpiUp {
    static constexpr int MID_T = 0;
    bf16_t* f; const float* gW; const float* bW; const float* convw; const float* convb; const float* ln_sum; const float* ln_sq;
    __device__ __forceinline__ void operator()(const AccT& acc, const Unit& u, int wr, int wc, int fr, int fq) const {
        const int feat0 = u.pn * 128 + wc * 32 + 8 * fq;
        const int pc0 = u.pn * 256 + wc * 32 + 8 * fq;
        const int rbase = u.pm * UP_TM + wr * 126 - 1 + 8 * fr;
        float ra[8], rb[8];
        unsigned vmask = 0, pmask = 0, nmask = 0;
        float sm[8], sq[8];
        {
            const f32x4 a0 = *(const f32x4u*)(ln_sum + rbase), a1 = *(const f32x4u*)(ln_sum + rbase + 4), b0 = *(const f32x4u*)(ln_sq + rbase), b1 = *(const f32x4u*)(ln_sq + rbase + 4);
#pragma unroll
            for (int e = 0; e < 4; ++e) { sm[e] = a0[e]; sm[4 + e] = a1[e]; sq[e] = b0[e]; sq[4 + e] = b1[e]; }
        }
#pragma unroll
        for (int i = 0; i < 8; ++i) {
            const int lr = 8 * fr + i;
            const int rowu = rbase + i; const int row = rowu < 0 ? 0 : (rowu >= M ? M - 1 : rowu);
            const float mu = sm[i] * (1.0f / D), var = fmaxf(sq[i] * (1.0f / D) - mu * mu, 0.f), rstd = __builtin_amdgcn_rsqf(var + LN_EPS);
            ra[i] = rstd; rb[i] = -rstd * mu;
            const int pos = row_pos(row), sl = row_slen(row);
            if ((lr >= 1) && (lr <= 126) && (rowu >= 0) && (rowu < M)) vmask |= 1u << i;
            if (pos != 0) pmask |= 1u << i;
            if (pos != sl - 1) nmask |= 1u << i;
        }
        const bool anyedge = __builtin_amdgcn_ballot_w64((pmask & nmask) != 0xffu) != 0ull;
        const float C1 = -2.0f * 0.7978845608028654f * 1.4426950408889634f, C2 = C1 * 0.044715f;
        u32x2 stash[8];
#pragma unroll
        for (int n = 0; n < 2; ++n) {
            const f32x4 gWg = *(const f32x4*)(gW + pc0 + 4 * n), bWg = *(const f32x4*)(bW + pc0 + 4 * n), gWv = *(const f32x4*)(gW + pc0 + 128 + 4 * n), bWv = *(const f32x4*)(bW + pc0 + 128 + 4 * n);
            const f32x4 w0 = *(const f32x4*)(convw + feat0 + 4 * n), w1 = *(const f32x4*)(convw + FF + feat0 + 4 * n), w2 = *(const f32x4*)(convw + 2 * FF + feat0 + 4 * n), cb = *(const f32x4*)(convb + feat0 + 4 * n);
#define GATE(i) (acc[(i) >> 2][0][(i) & 3][n] * ra[i] + (gWg * rb[i] + bWg))
            const f32x4 g0 = GATE(0), g7 = GATE(7);
            f32x4 gp, nlast;
#pragma unroll
            for (int e = 0; e < 4; ++e) { gp[e] = dpp_f<0x121>(g7[e]); nlast[e] = dpp_f<0x12F>(g0[e]); }
            f32x4 gc = g0;
#pragma unroll
            for (int i = 0; i < 8; ++i) {
                f32x4 gn = nlast;
                if (i < 6) gn = GATE(i + 1); else if (i == 6) gn = g7;
                const f32x4 val = acc[i >> 2][1][i & 3][n] * ra[i] + (gWv * rb[i] + bWv);
                f32x4 pv = gp, nv = gn;
                if (anyedge) { if (!((pmask >> i) & 1u)) pv = (f32x4){0.f, 0.f, 0.f, 0.f}; if (!((nmask >> i) & 1u)) nv = (f32x4){0.f, 0.f, 0.f, 0.f}; }
                const f32x4 cv = w0 * pv + (w1 * gc + (w2 * nv + cb));
                const f32x4 tt = cv * (cv * cv * C2 + C1);
                f32x4 o;
#pragma unroll
                for (int e = 0; e < 4; ++e) o[e] = cv[e] * fast_rcp(1.0f + fast_exp2(tt[e])) * val[e];
                const u32x2 pk = (u32x2){cvt_pk_bf16(o[0], o[1]), cvt_pk_bf16(o[2], o[3])};
                if (n == 0) stash[i] = pk;
                else if ((vmask >> i) & 1u) *(u32x4*)(f + (size_t)(rbase + i) * FF + feat0) = (u32x4){stash[i].x, stash[i].y, pk.x, pk.y};
                gp = gc; gc = gn;
            }
#undef GATE
        }
    }
};
struct EpiDown {
    static constexpr int MID_T = 0;
    const bf16_t* y1b; bf16_t* y2b; const float* g1; const float* b1; const float* ln1_sum; const float* ln1_sq; float* ln2_sum; float* ln2_sq;
    __device__ __forceinline__ void operator()(const AccT& acc, const Unit& u, int wr, int wc, int fr, int fq) const {
        const int col0 = u.pn * 256 + wc * 32 + 8 * fq;
#pragma unroll
        for (int ai = 0; ai < 2; ++ai)
#pragma unroll
            for (int m = 0; m < 4; ++m) {
                const int row = u.pm * 256 + ai * 128 + wr * 64 + m * 16 + fr;
                const float mu = ln1_sum[row] * (1.0f / D), var = ln1_sq[row] * (1.0f / D) - mu * mu, rstd = __builtin_amdgcn_rsqf(var + LN_EPS);
                float s1 = 0.f, s2 = 0.f;
#pragma unroll
                for (int bj = 0; bj < 2; ++bj) {
                    const int col = col0 + bj * 128;
                    const u32x4 yv = *(const u32x4*)(y1b + (size_t)row * D + col);
                    const f32x4 ya = (f32x4){bf_lo(yv.x), bf_hi(yv.x), bf_lo(yv.y), bf_hi(yv.y)}, yb = (f32x4){bf_lo(yv.z), bf_hi(yv.z), bf_lo(yv.w), bf_hi(yv.w)};
                    const f32x4 ga = *(const f32x4*)(g1 + col), gb = *(const f32x4*)(g1 + col + 4), ba = *(const f32x4*)(b1 + col), bb = *(const f32x4*)(b1 + col + 4);
                    const f32x4 za = ((ya - mu) * rstd * ga + ba) * DN_ALPHA + acc[ai][bj][m][0], zb = ((yb - mu) * rstd * gb + bb) * DN_ALPHA + acc[ai][bj][m][1];
#pragma unroll
                    for (int e = 0; e < 4; ++e) { s1 += za[e] + zb[e]; s2 += za[e] * za[e] + zb[e] * zb[e]; }
                    u32x4 w; w.x = cvt_pk_bf16(za[0], za[1]); w.y = cvt_pk_bf16(za[2], za[3]); w.z = cvt_pk_bf16(zb[0], zb[1]); w.w = cvt_pk_bf16(zb[2], zb[3]);
                    *(u32x4*)(y2b + (size_t)row * D + col) = w;
                }
                s1 += __shfl_xor(s1, 16); s1 += __shfl_xor(s1, 32); s2 += __shfl_xor(s2, 16); s2 += __shfl_xor(s2, 32);
                if (fq == 0) { atomicAdd(ln2_sum + row, s1); atomicAdd(ln2_sq + row, s2); }
                asm volatile("" ::: "memory");
            }
    }
};

__device__ __forceinline__ unsigned f2bf(float f) { unsigned u = __float_as_uint(f); return (u + 0x7fffu + ((u >> 16) & 1u)) >> 16; }
__device__ __forceinline__ unsigned pk2(float lo, float hi) { return f2bf(lo) | (f2bf(hi) << 16); }
template <int UPMAP>
__device__ __forceinline__ void p0_transpose_item(const float* W, int K, int N, bf16_t* WT, const float* ks, const float* ks2, LAS float* scr, int item, int lane) {
    const int nblk = N / 32, kb = item / nblk, nb = item % nblk, k0 = 64 * kb, n0 = 32 * nb;
#pragma unroll 8
    for (int i = 0; i < 32; ++i) { const int kk = 2 * i + (lane >> 5); float sc = 1.0f; if (ks) { const int kg = k0 + kk; sc = (ks2 && kg >= DH) ? ks2[kg - DH] : ks[kg]; }
        scr[kk * 33 + (lane & 31)] = W[(size_t)(k0 + kk) * N + n0 + (lane & 31)] * sc; }
    asm volatile("s_waitcnt lgkmcnt(0)" ::: "memory");
    const int c = lane & 7;
#pragma unroll
    for (int j = 0; j < 4; ++j) { const int n = (lane >> 3) + 8 * j; const LAS float* s = scr + (8 * c) * 33 + n;
        u32x4 o; o.x = pk2(s[0 * 33], s[1 * 33]); o.y = pk2(s[2 * 33], s[3 * 33]); o.z = pk2(s[4 * 33], s[5 * 33]); o.w = pk2(s[6 * 33], s[7 * 33]);
        int ng = n0 + n;
        if (UPMAP) { const int isv = ng >= FF, ft = isv ? ng - FF : ng; ng = 256 * (ft >> 7) + 128 * isv + (ft & 127); }
        *(u32x4*)(WT + (size_t)ng * K + k0 + 8 * c) = o; }
    asm volatile("s_waitcnt lgkmcnt(0)" ::: "memory");
}

__device__ __forceinline__ void p0_prep(KP P, LAS unsigned char* lds, int gw, int NGW, int lane) {
    unsigned char* ws = P->ws;
    const int wave = threadIdx.x >> 6;
    LAS float* scr = (LAS float*)(lds + wave * 16384);
    constexpr int I_IN = (D / 64) * (NIN / 32), I_GLU = (DH / 64) * (DH / 32), I_OUT = (D / 64) * (D / 32), I_UP = (D / 64) * (NUP / 32), I_DN = (FF / 64) * (D / 32);
    constexpr int NITEMS = I_IN + I_GLU + I_OUT + I_UP + I_DN;
    for (int it = gw; it < NITEMS; it += NGW) {
        int r = it;
        if (r < I_IN) { p0_transpose_item<0>(P->in[2], D, NIN, (bf16_t*)(ws + WS_WIN), nullptr, nullptr, scr, r, lane); continue; } r -= I_IN;
        if (r < I_GLU) { p0_transpose_item<0>(P->in[12], DH, DH, (bf16_t*)(ws + WS_WGLU), nullptr, nullptr, scr, r, lane); continue; } r -= I_GLU;
        if (r < I_OUT) { p0_transpose_item<0>(P->in[15], D, D, (bf16_t*)(ws + WS_WOUT), P->in[3], P->in[14], scr, r, lane); continue; } r -= I_OUT;
        if (r < I_UP) { p0_transpose_item<1>(P->in[18], D, NUP, (bf16_t*)(ws + WS_WUP), P->in[16], nullptr, scr, r, lane); continue; } r -= I_UP;
        p0_transpose_item<0>(P->in[21], FF, D, (bf16_t*)(ws + WS_WDN), nullptr, nullptr, scr, r, lane);
    }
    const int gt = gw * 64 + lane, NGT = NGW * 64;
    for (int it = gw; it < NUP / 4; it += NGW) {
        const float* w = P->in[18]; const float* g = P->in[16]; const float* b = P->in[17];
        const int n = it * 4 + (lane >> 4), kseg = lane & 15;
        float sg = 0.f, sb = 0.f;
#pragma unroll 8
        for (int kk = 0; kk < 64; ++kk) { const int k = kseg * 64 + kk; const float wv = w[(size_t)k * NUP + n]; sg += __uint_as_float(f2bf(g[k] * wv) << 16); sb += b[k] * wv; }
#pragma unroll
        for (int o = 1; o < 16; o <<= 1) { sg += __shfl_xor(sg, o); sb += __shfl_xor(sb, o); }
        if (kseg == 0) { const int isv = n >= FF, ft = isv ? n - FF : n, pc = 256 * (ft >> 7) + 128 * isv + (ft & 127);
            ((float*)(ws + WS_GW))[pc] = sg; ((float*)(ws + WS_BW))[pc] = sb; }
    }
    for (int i = gt; i < 6 * M / 4; i += NGT) ((f32x4*)(ws + WS_STATS))[i] = (f32x4){0.f, 0.f, 0.f, 0.f};
    for (int i = gt; i < 16384 * 8; i += NGT) {
        const int pos = i >> 3, j = i & 7;
        const double invf[8] = {1.0, 0.19392274474868576, 0.03760603093086393, 0.007292664737217109, 0.001414213562373095, 0.0002742481756762073, 5.318295896944988e-05, 1.031338537721246e-05};
        double fr_ = 1.0;
#pragma unroll
        for (int q = 0; q < 8; ++q) fr_ = (j == q) ? invf[q] : fr_;
        const double ang = (double)pos * fr_;
        const double k2 = rint(ang * 0.15915494309189535);
        const double red = fma(-k2, 6.283185307179586, ang) - k2 * 2.4492935982947064e-16;
        float sn, cs; sincosf((float)red, &sn, &cs);
        ((float*)(ws + WS_ROPEC))[i] = cs; ((float*)(ws + WS_ROPES))[i] = sn;
    }
    for (int i = gt; i < 2 * 32 * 64; i += NGT) {
        const int dg = i >> 6;
        const double dt = exp((double)P->in[6][dg]);
        const double are = P->in[4][i], aim = P->in[5][i];
        const double mag = exp(are * dt), ang = aim * dt;
        double lr = mag * cos(ang), li = mag * sin(ang);
        ((f32x2*)(ws + WS_LAM))[i] = (f32x2){(float)lr, (float)li};
        for (int q = 0; q < 5; ++q) { const double t = lr * lr - li * li; li = 2.0 * lr * li; lr = t; }
        ((f32x2*)(ws + WS_LAML))[i] = (f32x2){(float)lr, (float)li};
    }
    for (int i = gt; i < 2 * 32 * 8 * 64; i += NGT) {
        const int ln = i & 63, T = (i >> 6) & 7, dg = i >> 9;
        const int s = T >> 1, ri = T & 1, p = 16 * s + (ln & 15), q = ln >> 4;
        const double dt = exp((double)P->in[6][dg]);
        const double are = P->in[4][dg * 64 + p], aim = P->in[5][dg * 64 + p];
        const double mag = exp(are * dt), ang = aim * dt;
        const double lr = mag * cos(ang) - 1.0, li = mag * sin(ang);
        const double den = are * are + aim * aim;
        const double cr = (lr * are + li * aim) / den, ci = (li * are - lr * aim) / den;
        unsigned short v[8];
#pragma unroll
        for (int j = 0; j < 8; ++j) { const int c = 4 * q + (j & 3); const size_t bi = ((size_t)dg * 64 + p) * 16 + c;
            const double br = P->in[7][bi], bim = P->in[8][bi];
            const double o = ri == 0 ? (cr * br - ci * bim) : (cr * bim + ci * br);
            v[j] = j < 4 ? (unsigned short)f2bf((float)o) : (unsigned short)0; }
        ((u32x4*)(ws + WS_BFRAG))[i] = (u32x4){(unsigned)v[0] | ((unsigned)v[1] << 16), (unsigned)v[2] | ((unsigned)v[3] << 16), (unsigned)v[4] | ((unsigned)v[5] << 16), (unsigned)v[6] | ((unsigned)v[7] << 16)};
    }
    for (int i = gt; i < 32 * 5 * 64; i += NGT) {
        const int ln = i & 63, kb = (i >> 6) % 5, g = i / 320;
        const int ch = ln & 15, q = ln >> 4;
        unsigned short v[8];
#pragma unroll
        for (int jj = 0; jj < 8; ++jj) {
            if (kb < 4) { const int p = 16 * kb + 4 * q + (jj & 3); const size_t ci = ((size_t)g * 16 + ch) * 64 + p; v[jj] = (unsigned short)f2bf(jj < 4 ? P->in[9][ci] : -P->in[10][ci]); }
            else { const int c2 = 4 * q + (jj & 3); const float dv = P->in[11][g * 16 + ch]; const unsigned hi = f2bf(dv); const float lo = dv - __uint_as_float(hi << 16);
                   v[jj] = (c2 == ch) ? (unsigned short)(jj < 4 ? hi : f2bf(lo)) : (unsigned short)0; }
        }
        ((u32x4*)(ws + WS_CFRAG))[i] = (u32x4){(unsigned)v[0] | ((unsigned)v[1] << 16), (unsigned)v[2] | ((unsigned)v[3] << 16), (unsigned)v[4] | ((unsigned)v[5] << 16), (unsigned)v[6] | ((unsigned)v[7] << 16)};
    }
    for (size_t i = gt; i < (size_t)M * D / 8; i += NGT) {
        const size_t e = i * 8; const float* src = e < (size_t)MP * D ? P->in[0] + e : P->in[1] + (e - (size_t)MP * D);
        const f32x4 a = *(const f32x4*)src, b = *(const f32x4*)(src + 4);
        u32x4 w; w.x = cvt_pk_bf16(a[0], a[1]); w.y = cvt_pk_bf16(a[2], a[3]); w.z = cvt_pk_bf16(b[0], b[1]); w.w = cvt_pk_bf16(b[2], b[3]);
        ((u32x4*)(ws + WS_XB))[i] = w;
    }
}

constexpr int VROW = 144;
constexpr int ATT_ML = 131072;
struct AttBuf { bf16x8 kf[2][2]; u32x4 vreg[4]; };
__device__ __forceinline__ unsigned att_po(int t) { return (unsigned)((t >> 6) * 16384 + 8192 + (t & 63) * 128); }
template <int TYPE> __device__ __forceinline__ void att_step_params(int s, int i0, int t0, int& sh, int& mb) {
    if (TYPE == 0) { sh = s >= 5 ? 2 : 4; mb = s >= 5 ? (4 * i0 - 64 + 32 * (s - 5)) : (i0 - 64 + 32 * s); }
    else { sh = 0; mb = t0 - 64 + 32 * s; }
}
__device__ __forceinline__ void att_load(AttBuf& B, const bf16_t* __restrict__ Kt, const bf16_t* __restrict__ Vt, int sh, int mb, int r, int S, int sbrow, int h, int lane) {
    const int qi = lane & 15, g4 = lane >> 4;
    const int tlo = r + (mb << sh), thi = r + ((mb + 31) << sh);
    if (tlo >= 0 && thi < S) {
        const size_t ub = ((size_t)(sbrow + tlo) * DH + h * 64) * 2;
        const char* kb = (const char*)Kt + ub; const char* vb = (const char*)Vt + ub;
        const unsigned lk = (unsigned)(((qi << sh) * DH + 8 * g4) * 2), lv = (unsigned)((((lane >> 3) << sh) * DH + 8 * (lane & 7)) * 2);
        const unsigned bstep = (unsigned)((16 << sh) * DH * 2), vstep = (unsigned)((8 << sh) * DH * 2);
#pragma unroll
        for (int blk = 0; blk < 2; ++blk) { B.kf[blk][0] = *(const bf16x8*)(kb + blk * bstep + lk); B.kf[blk][1] = *(const bf16x8*)(kb + blk * bstep + lk + 64); }
#pragma unroll
        for (int i = 0; i < 4; ++i) B.vreg[i] = *(const u32x4*)(vb + i * vstep + lv);
    } else {
#pragma unroll
        for (int blk = 0; blk < 2; ++blk) {
            int tok = r + ((mb + 16 * blk + qi) << sh); tok = tok < 0 ? 0 : (tok >= S ? S - 1 : tok);
            const bf16_t* kp = Kt + (size_t)(sbrow + tok) * DH + h * 64 + 8 * g4;
            B.kf[blk][0] = *(const bf16x8*)kp; B.kf[blk][1] = *(const bf16x8*)(kp + 32);
        }
#pragma unroll
        for (int i = 0; i < 4; ++i) { const int idx = lane + 64 * i, rw = idx >> 3, ch = idx & 7;
            int tok = r + ((mb + rw) << sh); tok = tok < 0 ? 0 : (tok >= S ? S - 1 : tok);
            B.vreg[i] = *(const u32x4*)(Vt + (size_t)(sbrow + tok) * DH + h * 64 + 8 * ch); }
    }
}
__device__ __forceinline__ void att_comp(const AttBuf& B, const bf16x8 (&qf0)[2], f32x4 (&O)[2][4], float (&mrun)[2], float (&lsum)[2], LAS unsigned char* vl, unsigned vrd,
                                         int sh, int mb, int r, int S, int qp0, int qstep, int lane) {
    const int qi = lane & 15, g4 = lane >> 4;
    const float SC = 0.125f * 1.4426950408889634f;
#pragma unroll
    for (int i = 0; i < 4; ++i) { const int idx = lane + 64 * i, rw = idx >> 3, ch = idx & 7; *(LAS u32x4*)(vl + rw * VROW + ch * 16) = B.vreg[i]; }
    const int tlo = r + (mb << sh), thi = r + ((mb + 31) << sh);
    const bool edge = (tlo < 0) || (thi >= S);
    bf16x8 pf[2];
#pragma unroll
    for (int gq = 0; gq < 2; ++gq) {
        const int qg0 = qp0 + 16 * gq * qstep;
        if ((mb > qg0 + 15 * qstep + 64) || (mb + 31 < qg0 - 64)) { pf[gq] = (bf16x8){0, 0, 0, 0, 0, 0, 0, 0}; continue; }
        f32x4 sa[2];
        bf16x8 q0 = qf0[0], q1 = qf0[1];
        if (gq == 1) { q0 = *(const LAS bf16x8*)(vl + 4608 + lane * 16); q1 = *(const LAS bf16x8*)(vl + 4608 + 1024 + lane * 16); }
#pragma unroll
        for (int blk = 0; blk < 2; ++blk) {
            sa[blk] = __builtin_amdgcn_mfma_f32_16x16x32_bf16(B.kf[blk][0], q0, (f32x4){0.f, 0.f, 0.f, 0.f}, 0, 0, 0);
            sa[blk] = __builtin_amdgcn_mfma_f32_16x16x32_bf16(B.kf[blk][1], q1, sa[blk], 0, 0, 0);
        }
        const bool band = (mb < qg0 + 15 * qstep - 64) || (mb + 31 > qg0 + 64);
        float sv[8]; float mx;
        if (edge || band) {
            const int dbase = mb + 4 * g4 - (qg0 + qi * qstep) + 64;
            mx = -INFINITY;
#pragma unroll
            for (int blk = 0; blk < 2; ++blk)
#pragma unroll
                for (int j = 0; j < 4; ++j) {
                    bool ok = (unsigned)(dbase + 16 * blk + j) <= 128u;
                    if (edge) { const int tk = r + ((mb + 16 * blk + 4 * g4 + j) << sh); ok = ok && (tk >= 0) && (tk < S); }
                    const float x = ok ? sa[blk][j] : -INFINITY;
                    sv[blk * 4 + j] = x; mx = fmaxf(mx, x);
                }
        } else {
#pragma unroll
            for (int e = 0; e < 8; ++e) sv[e] = sa[e >> 2][e & 3];
            mx = fmaxf(fmaxf(fmaxf(sv[0], sv[1]), fmaxf(sv[2], sv[3])), fmaxf(fmaxf(sv[4], sv[5]), fmaxf(sv[6], sv[7])));
        }
        mx = fmaxf(mx, __shfl_xor(mx, 16)); mx = fmaxf(mx, __shfl_xor(mx, 32));
        const float mnew = fmaxf(mrun[gq], mx * SC);
        if (__builtin_amdgcn_ballot_w64(mnew > mrun[gq]) != 0ull) {
            const float alpha = fast_exp2(mrun[gq] - mnew);
            lsum[gq] *= alpha;
#pragma unroll
            for (int db = 0; db < 4; ++db) O[gq][db] *= alpha;
            mrun[gq] = mnew;
        }
        float p[8]; float ps = 0.f;
#pragma unroll
        for (int e = 0; e < 8; ++e) { p[e] = fast_exp2(sv[e] * SC - mrun[gq]); ps += p[e]; }
        lsum[gq] += ps;
        const u32x4 w = (u32x4){cvt_pk_bf16(p[0], p[1]), cvt_pk_bf16(p[2], p[3]), cvt_pk_bf16(p[4], p[5]), cvt_pk_bf16(p[6], p[7])}; pf[gq] = __builtin_bit_cast(bf16x8, w);
    }
#pragma unroll
    for (int db = 0; db < 4; ++db) {
        typedef short v4i16_t __attribute__((ext_vector_type(4)));
        const v4i16_t lo = __builtin_amdgcn_ds_read_tr16_b64_v4i16((LAS v4i16_t*)(vl + vrd + db * 32));
        const v4i16_t hi = __builtin_amdgcn_ds_read_tr16_b64_v4i16((LAS v4i16_t*)(vl + vrd + 16 * VROW + db * 32));
        const bf16x8 vf = (bf16x8){lo[0], lo[1], lo[2], lo[3], hi[0], hi[1], hi[2], hi[3]};
        O[0][db] = __builtin_amdgcn_mfma_f32_16x16x32_bf16(vf, pf[0], O[0][db], 0, 0, 0);
        O[1][db] = __builtin_amdgcn_mfma_f32_16x16x32_bf16(vf, pf[1], O[1][db], 0, 0, 0);
    }
}
template <int TYPE>
__device__ __forceinline__ void attn_tile(const bf16_t* __restrict__ Q, const bf16_t* __restrict__ Kt, const bf16_t* __restrict__ Vt, bf16_t* mix, float* ssq_a,
                                          LAS unsigned char* lds, LAS unsigned char* vl, int bb, int h, int idx, int lane) {
    constexpr int NS = TYPE == 0 ? 13 : 5;
    const int row0 = bb * 512;
    const int pos0 = row_pos(row0), S = row_slen(row0), sbrow = row0 - pos0;
    const int i0 = pos0 >> 4, t0 = pos0 + 32 * idx;
    const int qi = lane & 15, g4 = lane >> 4;
    const int r = TYPE == 0 ? idx : 0;
    int tq[2];
    bf16x8 qf[2];
#pragma unroll
    for (int gq = 0; gq < 2; ++gq) {
        tq[gq] = TYPE == 0 ? idx + 16 * (i0 + qi + 16 * gq) : t0 + qi + 16 * gq;
#pragma unroll
        for (int kk = 0; kk < 2; ++kk) { const bf16x8 qv = *(const bf16x8*)(Q + (size_t)(sbrow + tq[gq]) * DH + h * 64 + 32 * kk + 8 * g4);
            if (gq == 0) qf[kk] = qv; else *(LAS bf16x8*)(vl + 4608 + kk * 1024 + lane * 16) = qv; }
    }
    f32x4 O[2][4];
#pragma unroll
    for (int gq = 0; gq < 2; ++gq)
#pragma unroll
        for (int db = 0; db < 4; ++db) O[gq][db] = (f32x4){0.f, 0.f, 0.f, 0.f};
    float mrun[2] = {-1e30f, -1e30f}, lsum[2] = {0.f, 0.f};
    const unsigned vrd = (unsigned)((4 * g4 + ((lane & 15) >> 2)) * VROW + (lane & 3) * 8);
    AttBuf B0, B1, B2;
#define ATT_LOAD(B, s) do { int sh_, mb_; att_step_params<TYPE>((s), i0, t0, sh_, mb_); att_load(B, Kt, Vt, sh_, mb_, r, S, sbrow, h, lane); } while (0)
#define ATT_COMP(B, s) do { int sh_, mb_; att_step_params<TYPE>((s), i0, t0, sh_, mb_); \
        const int qstep_ = TYPE == 0 ? (16 >> sh_) : 1, qp0_ = TYPE == 0 ? qstep_ * i0 : t0; \
        att_comp(B, qf, O, mrun, lsum, vl, vrd, sh_, mb_, r, S, qp0_, qstep_, lane); } while (0)
    ATT_LOAD(B0, 0); ATT_LOAD(B1, 1);
    int s = 0;
#pragma unroll 1
    for (; s + 3 <= NS; s += 3) {
        if (s + 2 < NS) ATT_LOAD(B2, s + 2);
        ATT_COMP(B0, s);
        if (s + 3 < NS) ATT_LOAD(B0, s + 3);
        ATT_COMP(B1, s + 1);
        if (s + 4 < NS) ATT_LOAD(B1, s + 4);
        ATT_COMP(B2, s + 2);
    }
    if (NS % 3 >= 1) ATT_COMP(B0, s);
    if (NS % 3 >= 2) ATT_COMP(B1, s + 1);
#undef ATT_LOAD
#undef ATT_COMP
#pragma unroll
    for (int gq = 0; gq < 2; ++gq) {
        float ls = lsum[gq]; ls += __shfl_xor(ls, 16); ls += __shfl_xor(ls, 32);
        const int tb = tq[gq] - pos0;
        const unsigned po = att_po(tb), swz = (unsigned)((tb ^ (tb >> 4)) & 15);
        if (TYPE == 1) {
#pragma unroll
            for (int db = 0; db < 4; ++db) *(LAS u32x2*)(lds + po + (((unsigned)(4 * db + g4) ^ swz) << 3)) = (u32x2){cvt_pk_bf16(O[gq][db][0], O[gq][db][1]), cvt_pk_bf16(O[gq][db][2], O[gq][db][3])};
            if (g4 == 0) *(LAS f32x2*)(lds + ATT_ML + tb * 8) = (f32x2){mrun[gq], ls};
        } else {
            const f32x2 ml = *(const LAS f32x2*)(lds + ATT_ML + tb * 8);
            const float mm = fmaxf(mrun[gq], ml.x), ca = fast_exp2(mrun[gq] - mm), cb = fast_exp2(ml.x - mm);
            const float inv = 1.0f / (ls * ca + ml.y * cb);
            const float fa = ca * inv, fb = cb * inv;
            float ss = 0.f;
            bf16_t* orow = mix + (size_t)(sbrow + tq[gq]) * D + h * 64 + 4 * g4;
#pragma unroll
            for (int db = 0; db < 4; ++db) {
                const u32x2 obw = *(const LAS u32x2*)(lds + po + (((unsigned)(4 * db + g4) ^ swz) << 3));
                const f32x4 ob = (f32x4){bf_lo(obw.x), bf_hi(obw.x), bf_lo(obw.y), bf_hi(obw.y)};
                const f32x4 o = O[gq][db] * fa + ob * fb;
                ss += o[0] * o[0] + o[1] * o[1] + o[2] * o[2] + o[3] * o[3];
                *(u32x2*)(orow + 16 * db) = (u32x2){cvt_pk_bf16(o[0], o[1]), cvt_pk_bf16(o[2], o[3])};
            }
            ss += __shfl_xor(ss, 16); ss += __shfl_xor(ss, 32);
            if (g4 == 0) atomicAdd(ssq_a + sbrow + tq[gq], ss);
        }
    }
}

struct SsmPre { u32x2 ub[4]; float yf[4][4]; };
template <int MODE>
__device__ __forceinline__ void ssm_load(SsmPre& R, const bf16_t* __restrict__ U, const float* __restrict__ YF, unsigned uo, unsigned yo, int t0, int dir) {
    asm volatile("" : "+v"(uo), "+v"(yo));
#pragma unroll
    for (int k = 0; k < 4; ++k) {
        const unsigned tt = dir ? CL - 1 - (t0 + k) : t0 + k;
        R.ub[k] = *(const u32x2*)(U + (uo + tt * 16));
        if (MODE == 2) {
#pragma unroll
            for (int j = 0; j < 4; ++j) R.yf[k][j] = YF[yo + (j * CL + tt) * 16];
        }
    }
}
template <int MODE>
__device__ __forceinline__ void ssm_task(KP P, LAS unsigned char* lw, int sbk, int g, int dir, int lane) {
    unsigned char* ws = P->ws;
    const int c = lane & 15, q = lane >> 4, dg = dir * 32 + g;
    const bf16_t* U = (const bf16_t*)(ws + WS_U);
    float* YF = (float*)(ws + WS_YF);
    f32x2* ST = (f32x2*)(ws + WS_ST);
#pragma unroll
    for (int T = 0; T < 8; ++T) *(LAS u32x4*)(lw + T * 1024 + lane * 16) = ((const u32x4*)(ws + WS_BFRAG))[(dg * 8 + T) * 64 + lane];
    f32x4 lr[4], li[4], hr[4], hi[4];
#pragma unroll
    for (int s = 0; s < 4; ++s)
#pragma unroll
        for (int j = 0; j < 4; ++j) { const f32x2 l = ((const f32x2*)(ws + WS_LAM))[dg * 64 + 16 * s + 4 * q + j]; lr[s][j] = l.x; li[s][j] = l.y; hr[s][j] = 0.f; hi[s][j] = 0.f; }
    const int chunk = sbk * 16 + c;
    const size_t stbase = ((size_t)dg * NCHUNK + chunk) * 64;
    if (MODE != 0) {
#pragma unroll
        for (int s = 0; s < 4; ++s)
#pragma unroll
            for (int j = 0; j < 4; ++j) { const f32x2 v = ST[stbase + 16 * s + 4 * q + j]; hr[s][j] = v.x; hi[s][j] = v.y; }
    }
    if (MODE != 0) {
#pragma unroll
        for (int kb = 0; kb < 5; ++kb) *(LAS u32x4*)(lw + 8192 + kb * 1024 + lane * 16) = ((const u32x4*)(ws + WS_CFRAG))[(g * 5 + kb) * 64 + lane];
    }
#define BFR(T) (*(const LAS bf16x8*)(lw + (T) * 1024 + lane * 16))
#define CFR(kb) (*(const LAS bf16x8*)(lw + 8192 + (kb) * 1024 + lane * 16))
    unsigned uo = ((unsigned)g * M + (unsigned)chunk * CL) * 16 + 4 * q;
    unsigned yo = ((unsigned)g * M + (unsigned)(sbk * 16 + 4 * q) * CL) * 16 + c;
    SsmPre R0, R1;
#define SSM_STEP(R, k, t) do { \
        asm volatile("" : "+v"(yo) :: "memory"); \
        const bf16x8 ub = __builtin_bit_cast(bf16x8, ((u32x4){R.ub[k].x, R.ub[k].y, R.ub[k].x, R.ub[k].y})); \
        bf16x8 cfl[4], cf4; \
        if (MODE != 0) { _Pragma("unroll") for (int kb = 0; kb < 4; ++kb) cfl[kb] = CFR(kb); cf4 = CFR(4); } \
        f32x4 bu[8]; \
        _Pragma("unroll") for (int T = 0; T < 8; ++T) bu[T] = __builtin_amdgcn_mfma_f32_16x16x32_bf16(BFR(T), ub, (f32x4){0.f, 0.f, 0.f, 0.f}, 0, 0, 0); \
        _Pragma("unroll") for (int s = 0; s < 4; ++s) { \
            const f32x4 nr = lr[s] * hr[s] - li[s] * hi[s] + bu[2 * s], ni = lr[s] * hi[s] + li[s] * hr[s] + bu[2 * s + 1]; \
            hr[s] = nr; hi[s] = ni; } \
        if (MODE != 0) { \
            f32x4 y = (f32x4){0.f, 0.f, 0.f, 0.f}, y2 = (f32x4){0.f, 0.f, 0.f, 0.f}; \
            if (MODE == 1) y2 = __builtin_amdgcn_mfma_f32_16x16x32_bf16(ub, cf4, y2, 0, 0, 0); \
            _Pragma("unroll") for (int kb = 0; kb < 4; ++kb) { \
                const u32x4 w = (u32x4){cvt_pk_bf16(hr[kb][0], hr[kb][1]), cvt_pk_bf16(hr[kb][2], hr[kb][3]), cvt_pk_bf16(hi[kb][0], hi[kb][1]), cvt_pk_bf16(hi[kb][2], hi[kb][3])}; \
                if (kb & 1) y2 = __builtin_amdgcn_mfma_f32_16x16x32_bf16(__builtin_bit_cast(bf16x8, w), cfl[kb], y2, 0, 0, 0); \
                else y = __builtin_amdgcn_mfma_f32_16x16x32_bf16(__builtin_bit_cast(bf16x8, w), cfl[kb], y, 0, 0, 0); } \
            y += y2; \
            const unsigned tt = dir ? CL - 1 - (t) : (t); \
            _Pragma("unroll") for (int j = 0; j < 4; ++j) { \
                const unsigned oi = yo + (j * CL + tt) * 16; \
                if (MODE == 1) YF[oi] = y[j]; \
                else ((bf16_t*)(ws + WS_SPRE))[oi] = (bf16_t)(cvt_pk_bf16(gelu_tanh(y[j] + R.yf[k][j]), 0.f) & 0xffffu); } \
        } __builtin_amdgcn_sched_barrier(0); } while (0)
    SsmPre R2;
    ssm_load<MODE>(R0, U, YF, uo, yo, 0, dir);
    ssm_load<MODE>(R1, U, YF, uo, yo, 4, dir);
#define SSM_BLK(R, t0) do { SSM_STEP(R, 0, (t0)); SSM_STEP(R, 1, (t0) + 1); SSM_STEP(R, 2, (t0) + 2); SSM_STEP(R, 3, (t0) + 3); } while (0)
    ssm_load<MODE>(R2, U, YF, uo, yo, 8, dir);  SSM_BLK(R0, 0);
    ssm_load<MODE>(R0, U, YF, uo, yo, 12, dir); SSM_BLK(R1, 4);
    ssm_load<MODE>(R1, U, YF, uo, yo, 16, dir); SSM_BLK(R2, 8);
    ssm_load<MODE>(R2, U, YF, uo, yo, 20, dir); SSM_BLK(R0, 12);
    ssm_load<MODE>(R0, U, YF, uo, yo, 24, dir); SSM_BLK(R1, 16);
    ssm_load<MODE>(R1, U, YF, uo, yo, 28, dir); SSM_BLK(R2, 20);
    SSM_BLK(R0, 24);
    SSM_BLK(R1, 28);
#undef SSM_BLK
#undef SSM_STEP
#undef BFR
#undef CFR
    if (MODE == 0) {
#pragma unroll
        for (int s = 0; s < 4; ++s)
#pragma unroll
            for (int j = 0; j < 4; ++j) ST[stbase + 16 * s + 4 * q + j] = (f32x2){hr[s][j], hi[s][j]};
    }
}
__device__ __forceinline__ void ssm_carry(KP P, int gt, int NGT) {
    unsigned char* ws = P->ws; f32x2* ST = (f32x2*)(ws + WS_ST);
    for (int i = gt; i < 64 * 10 * 64; i += NGT) {
        const int p = i & 63, sq = (i >> 6) % 10, dg = i / 640, dir = dg >> 5;
        const int c0 = (sq < 2 ? sq * 16384 : MP + (sq - 2) * 8192) / CL, nc = (sq < 2 ? 16384 : 8192) / CL;
        const f32x2 L = ((const f32x2*)(ws + WS_LAML))[dg * 64 + p];
        f32x2 carry = (f32x2){0.f, 0.f};
        f32x2* base = ST + ((size_t)dg * NCHUNK + c0) * 64 + p;
        for (int k0 = 0; k0 < nc; k0 += 32) {
            f32x2 e[32];
#pragma unroll
            for (int k = 0; k < 32; ++k) { const int ck = dir ? nc - 1 - (k0 + k) : k0 + k; e[k] = base[(size_t)ck * 64]; }
#pragma unroll
            for (int k = 0; k < 32; ++k) { const int ck = dir ? nc - 1 - (k0 + k) : k0 + k; base[(size_t)ck * 64] = carry;
                const float cr = L.x * carry.x - L.y * carry.y + e[k].x, ci = L.x * carry.y + L.y * carry.x + e[k].y; carry = (f32x2){cr, ci}; }
        }
    }
}

constexpr int LDS_BYTES = 147456;
__global__ void __launch_bounds__(512, 2) mega_fwd(Params Pval, int ph_lo, int ph_hi) {
    KP P = (KP)__builtin_amdgcn_kernarg_segment_ptr();
    extern __shared__ __attribute__((aligned(16))) unsigned char lds_raw[];
    LAS unsigned char* lds = (LAS unsigned char*)lds_raw;
    cg::grid_group grid = cg::this_grid();
    const int tid = threadIdx.x, lane = tid & 63, wave = __builtin_amdgcn_readfirstlane(tid >> 6);
    const int G = gridDim.x, bx = blockIdx.x;
    const int gw = bx * 8 + wave, NGW = G * 8;
    const int vgw = ((G & 7) == 0 ? (bx & 7) * (G >> 3) + (bx >> 3) : bx) * 8 + wave;
#define PHASE_VARS asm volatile("" : "+s"(P)); unsigned char* ws = P->ws; float* stats = (float*)(ws + WS_STATS); \
    float* ssq_a = stats, *ssq_s = stats + M, *ln1_sum = stats + 2 * M, *ln1_sq = stats + 3 * M, *ln2_sum = stats + 4 * M, *ln2_sq = stats + 5 * M; \
    (void)ssq_a; (void)ssq_s; (void)ln1_sum; (void)ln1_sq; (void)ln2_sum; (void)ln2_sq;
#ifndef PH_MASK
#define PH_MASK 0x7ff
#endif
#define IN(k) (((PH_MASK >> (k)) & 1) && ph_lo <= (k) && (k) < ph_hi)
#define SEAM(k) do { if (ph_lo <= (k) && (k) + 1 < ph_hi) grid.sync(); } while (0)
    if (IN(0)) { asm volatile("" : "+s"(P)); p0_prep(P, lds, gw, NGW, lane); }
    SEAM(0);
    if (IN(1)) {
        PHASE_VARS
        pg8::Gemm g{(const bf16_t*)(ws + WS_XB), (const bf16_t*)(ws + WS_WIN), D}; pg8::StaticOrder S; S.init(M / 256, NIN / 256, G, bx);
        EpiIn E{(bf16_t*)(ws + WS_Q), (const float*)(ws + WS_ROPEC), (const float*)(ws + WS_ROPES)};
        pg8::gemm_phase<EpiIn, 0>(lds, g, S, E);
    }
    SEAM(1);
    if (IN(2)) {
        PHASE_VARS
        for (int it = bx; it < (M / 512) * 8; it += G) {
            const int bb = it >> 3, h = it & 7;
            const bf16_t* Qp = (const bf16_t*)(ws + WS_Q); const bf16_t* Kp = (const bf16_t*)(ws + WS_K); const bf16_t* Vp = (const bf16_t*)(ws + WS_V);
            for (int j = wave; j < 16; j += 8) attn_tile<1>(Qp, Kp, Vp, (bf16_t*)(ws + WS_MIX), ssq_a, lds, lds + wave * 16384, bb, h, j, lane);
            __syncthreads();
            for (int r = wave; r < 16; r += 8) attn_tile<0>(Qp, Kp, Vp, (bf16_t*)(ws + WS_MIX), ssq_a, lds, lds + wave * 16384, bb, h, r, lane);
            __syncthreads();
        }
        for (int it = vgw; it < (M / (16 * CL)) * 64; it += NGW) ssm_task<0>(P, lds + wave * 16384, it >> 6, it & 31, (it >> 5) & 1, lane);
    }
    SEAM(2);
    if (IN(3)) { asm volatile("" : "+s"(P)); } if (IN(3)) ssm_carry(P, gw * 64 + lane, NGW * 64);
    SEAM(3);
    if (IN(4)) { asm volatile("" : "+s"(P)); for (int it = vgw; it < (M / (16 * CL)) * 32; it += NGW) ssm_task<1>(P, lds + wave * 16384, it >> 5, it & 31, 0, lane); }
    SEAM(4);
    if (IN(5)) { asm volatile("" : "+s"(P)); for (int it = vgw; it < (M / (16 * CL)) * 32; it += NGW) ssm_task<2>(P, lds + wave * 16384, it >> 5, it & 31, 1, lane); }
    SEAM(5);
    if (IN(6)) {
        PHASE_VARS
        pg8::Gemm g{(const bf16_t*)(ws + WS_SPRE), (const bf16_t*)(ws + WS_WGLU), DH}; pg8::StaticOrder S; S.init(M / 256, DH / 256, G, bx);
        EpiGlu E{(const bf16_t*)(ws + WS_SPRE), (bf16_t*)(ws + WS_MIX), P->in[13], ssq_s};
        pg8::gemm_phase<EpiGlu, 2>(lds, g, S, E);
    }
    SEAM(6);
    if (IN(7)) {
        PHASE_VARS
        pg8::Gemm g{(const bf16_t*)(ws + WS_MIX), (const bf16_t*)(ws + WS_WOUT), D}; pg8::StaticOrder S; S.init(M / 256, D / 256, G, bx);
        EpiOut E{P->in[0], P->in[1], P->out, (bf16_t*)(ws + WS_Y1B), ssq_a, ssq_s, ln1_sum, ln1_sq};
        pg8::gemm_phase<EpiOut, 0>(lds, g, S, E);
    }
    SEAM(7);
    if (IN(8)) {
        PHASE_VARS
        pg8::Gemm g{(const bf16_t*)(ws + WS_Y1B) - D, (const bf16_t*)(ws + WS_WUP), D}; pg8::StaticOrder S; S.init(UP_NM, NUP / 256, G, bx);
        EpiUp E{(bf16_t*)(ws + WS_F), (const float*)(ws + WS_GW), (const float*)(ws + WS_BW), P->in[19], P->in[20], ln1_sum, ln1_sq};
        pg8::gemm_phase<EpiUp, 1>(lds, g, S, E);
    }
    SEAM(8);
    if (IN(9)) {
        PHASE_VARS
        pg8::Gemm g{(const bf16_t*)(ws + WS_F), (const bf16_t*)(ws + WS_WDN), FF}; pg8::StaticOrder S; S.init(M / 256, D / 256, G, bx);
        EpiDown E{(const bf16_t*)(ws + WS_Y1B), (bf16_t*)(ws + WS_MIX), P->in[16], P->in[17], ln1_sum, ln1_sq, ln2_sum, ln2_sq};
        pg8::gemm_phase<EpiDown, 0>(lds, g, S, E);
    }
    SEAM(9);
    if (IN(10)) {
        PHASE_VARS
        const float* g2 = P->in[22]; const float* b2 = P->in[23]; const bf16_t* y2b = (const bf16_t*)(ws + WS_MIX); float* outp = P->out;
        for (int row = gw; row < M; row += NGW) {
            const float mu = ln2_sum[row] * (1.0f / D), var = ln2_sq[row] * (1.0f / D) - mu * mu, rstd = __builtin_amdgcn_rsqf(var + LN_EPS);
#pragma unroll
            for (int j = 0; j < 2; ++j) {
                const int col = 512 * j + 8 * lane;
                const u32x4 yv = *(const u32x4*)(y2b + (size_t)row * D + col);
                const f32x4 ya = (f32x4){bf_lo(yv.x), bf_hi(yv.x), bf_lo(yv.y), bf_hi(yv.y)}, yb = (f32x4){bf_lo(yv.z), bf_hi(yv.z), bf_lo(yv.w), bf_hi(yv.w)};
                const f32x4 ga = *(const f32x4*)(g2 + col), gb = *(const f32x4*)(g2 + col + 4), ba = *(const f32x4*)(b2 + col), bb = *(const f32x4*)(b2 + col + 4);
                *(f32x4*)(outp + (size_t)row * D + col) = (ya - mu) * rstd * ga + ba;
                *(f32x4*)(outp + (size_t)row * D + col + 4) = (yb - mu) * rstd * gb + bb;
            }
        }
    }
#undef IN
#undef SEAM
}

extern "C" void kernel_launch(void* const* d_in, const int* in_sizes, int n_in, void* d_out, int out_size, void* d_ws, size_t ws_size, hipStream_t stream) {
    static int grid = 0;
    if (grid == 0) {
        if (n_in != 24 || ws_size < WS_END) { fprintf(stderr, "kernel_launch: unexpected n_in %d / ws_size %zu (need %zu)\n", n_in, ws_size, (size_t)WS_END); grid = -1; return; }
        int dev = 0, cus = 0, per_cu = 0;
        hipGetDevice(&dev); hipDeviceGetAttribute(&cus, hipDeviceAttributeMultiprocessorCount, dev);
        hipFuncSetAttribute((const void*)mega_fwd, hipFuncAttributeMaxDynamicSharedMemorySize, LDS_BYTES);
        hipOccupancyMaxActiveBlocksPerMultiprocessor(&per_cu, (const void*)mega_fwd, 512, LDS_BYTES);
        (void)hipGetLastError();
        if (per_cu < 1) per_cu = 1;
        grid = cus * per_cu;
    }
    if (grid < 0) return;
    Params p{};
    for (int i = 0; i < 24; ++i) p.in[i] = (const float*)d_in[i];
    p.out = (float*)d_out; p.ws = (unsigned char*)d_ws;
    int lo = 0, hi = 11;
    void* args[] = {&p, &lo, &hi};
    hipError_t e = hipLaunchCooperativeKernel((const void*)mega_fwd, dim3(grid), dim3(512), args, LDS_BYTES, stream);
    if (e != hipSuccess) fprintf(stderr, "cooperative launch failed: %s (grid %d)\n", hipGetErrorString(e), grid);
}
```

```cpp
#include <hip/hip_runtime.h>
#include <hip/hip_cooperative_groups.h>
#include <cstdio>
#include <cstdint>
namespace cg = cooperative_groups;

#define LAS __attribute__((address_space(3)))
typedef unsigned short bf16_t;
typedef short bf16x8 __attribute__((ext_vector_type(8)));
typedef short bf16x4 __attribute__((ext_vector_type(4)));
typedef float f32x4 __attribute__((ext_vector_type(4)));
typedef float f32x2 __attribute__((ext_vector_type(2)));
typedef f32x4 f32x4u __attribute__((aligned(4)));
typedef unsigned u32x4 __attribute__((ext_vector_type(4)));
typedef unsigned u32x2 __attribute__((ext_vector_type(2)));

constexpr int M = 98304, D = 1024, NIN = 2048, DH = 512, FF = 2816, NUP = 5632;
constexpr int MP = 32768;
constexpr int CL = 32;
constexpr int NCHUNK = M / CL;
constexpr float LN_EPS = 1e-5f;
constexpr float DN_ALPHA = 1.189207115002721f;
constexpr int UP_TM = 252;
constexpr int UP_NM = (M + UP_TM - 1) / UP_TM;

constexpr size_t MiB = 1u << 20;
constexpr size_t WS_STATS = 0;
constexpr size_t WS_ROPEC = 3 * MiB, WS_ROPES = WS_ROPEC + 16384 * 8 * 4;
constexpr size_t WS_LAM = 4 * MiB + 0;
constexpr size_t WS_LAML = WS_LAM + 32768;
constexpr size_t WS_BFRAG = WS_LAML + 32768;
constexpr size_t WS_CFRAG = WS_BFRAG + 524288;
constexpr size_t WS_GW = WS_CFRAG + 163840;
constexpr size_t WS_BW = WS_GW + 32768;
static_assert(WS_BW + 32768 <= 5 * MiB, "tables");
constexpr size_t WS_WIN = 5 * MiB;
constexpr size_t WS_WGLU = 9 * MiB;
constexpr size_t WS_WOUT = 10 * MiB;
constexpr size_t WS_WUP = 12 * MiB;
constexpr size_t WS_WDN = 24 * MiB;
constexpr size_t WS_A = 32 * MiB;
constexpr size_t WS_XB = WS_A, WS_Q = WS_A + 192 * MiB, WS_K = WS_Q + 96 * MiB, WS_V = WS_K + 96 * MiB, WS_U = WS_V + 96 * MiB;
constexpr size_t WS_YF = WS_XB;
constexpr size_t WS_SPRE = WS_Q;
constexpr size_t WS_F = WS_A;
constexpr size_t WS_MIX = WS_A + 576 * MiB;
constexpr size_t WS_Y1B = WS_MIX + 192 * MiB + 1 * MiB;
constexpr size_t WS_ST = WS_Y1B;
constexpr size_t WS_END = WS_Y1B + 192 * MiB + 1 * MiB;
static_assert(WS_END <= 1024 * MiB, "workspace map must fit 1 GiB");
static_assert(CL == 32, "the scan's prefetch ring is written out for 8 blocks of 4 steps");

__device__ __forceinline__ unsigned cvt_pk_bf16(float lo, float hi) { unsigned r; asm volatile("v_cvt_pk_bf16_f32 %0, %1, %2" : "=v"(r) : "v"(lo), "v"(hi)); return r; }
__device__ __forceinline__ float bf_lo(unsigned w) { return __uint_as_float(w << 16); }
__device__ __forceinline__ float bf_hi(unsigned w) { return __uint_as_float(w & 0xffff0000u); }
__device__ __forceinline__ float fast_exp2(float x) { return __builtin_amdgcn_exp2f(x); }
__device__ __forceinline__ float fast_rcp(float x) { return __builtin_amdgcn_rcpf(x); }
__device__ __forceinline__ float gelu_tanh(float x) {
    const float u = x * (1.0f + 0.044715f * x * x);
    const float e = fast_exp2(u * (-2.0f * 0.7978845608028654f * 1.4426950408889634f));
    return x * fast_rcp(1.0f + e);
}
__device__ __forceinline__ float sigmoidf_(float z) { return fast_rcp(1.0f + fast_exp2(-1.4426950408889634f * z)); }
__device__ __forceinline__ int row_pos(int row) { return row < MP ? (row & 16383) : (row & 8191); }
__device__ __forceinline__ int row_slen(int row) { return row < MP ? 16384 : 8192; }
template <int CTRL> __device__ __forceinline__ float dpp_f(float v) { return __int_as_float(__builtin_amdgcn_update_dpp(0, __float_as_int(v), CTRL, 0xF, 0xF, false)); }

struct Params {
    const float* in[24];
    float* out;
    unsigned char* ws;
};
typedef const __attribute__((address_space(4))) Params* KP;

namespace pg8 {
constexpr int BM = 256, BK = 64, HALF = 128, HTB = HALF * BK * 2, STAGE_BYTES = 8 * HTB, NXCD = 8, WGM = 8;
__device__ __forceinline__ int lds_byte(int r, int c) { const int st = (r >> 4) * 2 + (c >> 5), rr = r & 15, cc = c & 31, ob = rr * 64 + cc * 2; return st * 1024 + (ob ^ (((ob >> 9) & 1) << 5)); }
__device__ __forceinline__ void stage_rc(int b, int& R, int& C) { const int st = b / 1024, sb = b % 1024, swz = sb ^ (((sb >> 9) & 1) << 5); R = (st >> 1) * 16 + swz / 64; C = (st & 1) * 32 + (swz % 64) / 2; }
__device__ __forceinline__ int perm32(int rho) { const int n = rho >> 4, i = rho & 15; return 8 * (i >> 2) + 4 * n + (i & 3); }
struct Unit { int pm, pn; };
struct Gemm { const bf16_t* A; const bf16_t* Bt; int K; };
struct StaticOrder {
    int nM, nN, nwg, G, c;
    __device__ void init(int nM_, int nN_, int G_, int c_) { nM = nM_; nN = nN_; nwg = nM * nN; G = G_; c = c_; }
    __device__ bool next(int i, Unit& u) const {
        const long L = (long)i * G + c; if (L >= nwg) return false;
        int wgid = (int)L; { const int q = nwg / NXCD, r = nwg % NXCD, xcd = wgid % NXCD, off = wgid / NXCD; wgid = (xcd < r ? xcd * (q + 1) : r * (q + 1) + (xcd - r) * q) + off; }
        const int nig = WGM * nN, gid = wgid / nig, fm = gid * WGM, gsz = (nM - fm) < WGM ? (nM - fm) : WGM;
        u.pm = fm + ((wgid % nig) % gsz); u.pn = (wgid % nig) / gsz; return true;
    }
};

template <class Epi, int AMODE>
__device__ __forceinline__ void gemm_phase(LAS unsigned char* lds, const Gemm g, const StaticOrder& S, const Epi& E) {
    const int tid = threadIdx.x, wid = __builtin_amdgcn_readfirstlane(tid >> 6), lane = tid & 63, wr = wid >> 2, wc = wid & 3, fr = lane & 15, fq = lane >> 4;
    constexpr bool SPLIT2 = Epi::MID_T > 0;
    const int K = g.K, nt = SPLIT2 ? K / BK / 2 : K / BK;
    const size_t koff = (size_t)K;
    unsigned voffA[2], voffB[2];
#pragma unroll
    for (int i = 0; i < 2; ++i) { int R, C; stage_rc(tid * 16 + i * 8192, R, C); const int Rb = (R & ~31) + perm32(R & 31);
        const int Ra = AMODE == 1 ? (126 * (R >> 6) + 8 * (R & 15) + ((R >> 4) & 3)) : R;
        voffA[i] = AMODE == 2 ? (unsigned)(((C >> 4) * M + R) * 32 + (C & 15) * 2) : (unsigned)(Ra * K + C) * 2u; voffB[i] = (unsigned)(Rb * K + C) * 2u; }
    const size_t kstep = (size_t)(BK * 2);
    const size_t hstepB = (size_t)HALF * K * 2, tstepB = 2 * hstepB;
    const size_t hstepA = AMODE == 1 ? (size_t)4 * K * 2 : (AMODE == 2 ? (size_t)HALF * 32 : hstepB), tstepA = AMODE == 1 ? (size_t)UP_TM * K * 2 : (AMODE == 2 ? (size_t)BM * 32 : tstepB);
    const size_t kstepA = AMODE == 2 ? (size_t)4 * M * 32 : kstep;
    const unsigned ldsw = (unsigned)wid * 1024u;
    const int aoff = lds_byte(wr * 64 + fr, fq * 8), boff = lds_byte(wc * 32 + fr, fq * 8);
#define PG8_SA(b, h) (((b) * 2 + (h)) * HTB)
#define PG8_SB(b, h) ((4 + (b) * 2 + (h)) * HTB)
#define PG8_STAGE(bufoff, gbase, voff) do { _Pragma("unroll") for (int _i = 0; _i < 2; ++_i) \
        __builtin_amdgcn_global_load_lds((const unsigned*)((const char*)(gbase) + (voff)[_i]), (LAS unsigned*)(lds + (bufoff) + ldsw + _i * 8192), 16, 0, 0); } while (0)
#define PG8_LDA(dst, b, h) do { _Pragma("unroll") for (int m = 0; m < 4; ++m) _Pragma("unroll") for (int k = 0; k < 2; ++k) dst[m][k] = *(const LAS bf16x8*)(lds + PG8_SA(b, h) + aoff + m * 2048 + k * 1024); } while (0)
#define PG8_LDB(dst, b, h) do { _Pragma("unroll") for (int n = 0; n < 2; ++n) _Pragma("unroll") for (int k = 0; k < 2; ++k) dst[n][k] = *(const LAS bf16x8*)(lds + PG8_SB(b, h) + boff + n * 2048 + k * 1024); } while (0)
#define PG8_MMA(ai, bj, At, Bt) do { __builtin_amdgcn_s_setprio(1); _Pragma("unroll") for (int m = 0; m < 4; ++m) _Pragma("unroll") for (int n = 0; n < 2; ++n) _Pragma("unroll") for (int k = 0; k < 2; ++k) \
        acc[ai][bj][m][n] = __builtin_amdgcn_mfma_f32_16x16x32_bf16(Bt[n][k], At[m][k], acc[ai][bj][m][n], 0, 0, 0); __builtin_amdgcn_s_setprio(0); } while (0)
#define PG8_WAIT_V(n) asm volatile("s_waitcnt vmcnt(" #n ")" ::: "memory")
#define PG8_WAIT_L(n) asm volatile("s_waitcnt lgkmcnt(" #n ")" ::: "memory")
#define PG8_BAR __builtin_amdgcn_s_barrier()
#define PG8_SCHED __builtin_amdgcn_sched_barrier(0)
    Unit cur, nxt; int ui = 0;
    if (!S.next(0, cur)) return;
#define PG8_HALF(i) (SPLIT2 ? ((i) & 1) : 0)
#define PG8_NEXT(i, u) (SPLIT2 ? S.next((i) >> 1, u) : S.next((i), u))
    f32x4 acc[2][2][4][2];
#pragma unroll
    for (int a = 0; a < 2; ++a)
#pragma unroll
        for (int b = 0; b < 2; ++b)
#pragma unroll
            for (int m = 0; m < 4; ++m)
#pragma unroll
                for (int n = 0; n < 2; ++n) acc[a][b][m][n] = (f32x4){0.f, 0.f, 0.f, 0.f};
    bf16x8 At[4][2], B0[2][2], B1[2][2];
    const char* cA = (const char*)g.A + (size_t)cur.pm * tstepA; const char* cB = (const char*)g.Bt + (size_t)cur.pn * tstepB;
    PG8_STAGE(PG8_SB(0, 0), cB, voffB); PG8_STAGE(PG8_SB(0, 1), cB + hstepB, voffB); PG8_STAGE(PG8_SA(0, 0), cA, voffA); PG8_STAGE(PG8_SA(0, 1), cA + hstepA, voffA);
    if (wr == 1) PG8_BAR;
    PG8_WAIT_V(2); PG8_BAR;
    PG8_STAGE(PG8_SB(1, 0), cB + kstep, voffB); PG8_STAGE(PG8_SA(1, 0), cA + kstepA, voffA); PG8_STAGE(PG8_SB(1, 1), cB + hstepB + kstep, voffB);
    PG8_WAIT_V(6); PG8_BAR;
    for (;;) {
        const bool has_next = PG8_NEXT(ui + 1, nxt);
        const char* nA = has_next ? (const char*)g.A + (size_t)nxt.pm * tstepA + PG8_HALF(ui + 1) * koff : cA; const char* nB = has_next ? (const char*)g.Bt + (size_t)nxt.pn * tstepB + PG8_HALF(ui + 1) * koff : cB;
        for (int t = 0; t < nt; t += 2) {
            const bool last = (t == nt - 2);
            const char* a1 = cA + (size_t)(t + 1) * kstepA;
            const char* a2 = last ? nA : cA + (size_t)(t + 2) * kstepA; const char* b2 = last ? nB : cB + (size_t)(t + 2) * kstep;
            const char* a3 = a2 + kstepA; const char* b3 = b2 + kstep;
            PG8_LDB(B0, 0, 0); PG8_LDB(B1, 0, 1); PG8_SCHED; PG8_LDA(At, 0, 0); PG8_STAGE(PG8_SA(1, 1), a1 + hstepA, voffA);
            PG8_WAIT_V(8); PG8_WAIT_L(0); PG8_BAR; PG8_MMA(0, 0, At, B0); PG8_MMA(0, 1, At, B1); PG8_BAR; PG8_SCHED;
            PG8_LDA(At, 0, 1); PG8_STAGE(PG8_SB(0, 0), b2, voffB); PG8_STAGE(PG8_SB(0, 1), b2 + hstepB, voffB); PG8_STAGE(PG8_SA(0, 0), a2, voffA);
            PG8_WAIT_V(8); PG8_WAIT_L(0); PG8_BAR; PG8_MMA(1, 0, At, B0); PG8_MMA(1, 1, At, B1); PG8_BAR; PG8_SCHED;
            PG8_LDB(B0, 1, 0); PG8_LDB(B1, 1, 1); PG8_SCHED; PG8_LDA(At, 1, 0); PG8_STAGE(PG8_SA(0, 1), a2 + hstepA, voffA);
            PG8_WAIT_V(8); PG8_WAIT_L(0); PG8_BAR; PG8_MMA(0, 0, At, B0); PG8_MMA(0, 1, At, B1); PG8_BAR; PG8_SCHED;
            PG8_LDA(At, 1, 1); PG8_STAGE(PG8_SB(1, 0), b3, voffB); PG8_STAGE(PG8_SB(1, 1), b3 + hstepB, voffB); PG8_STAGE(PG8_SA(1, 0), a3, voffA);
            PG8_WAIT_V(8); PG8_WAIT_L(0); PG8_BAR; PG8_MMA(1, 0, At, B0); PG8_MMA(1, 1, At, B1); PG8_BAR; PG8_SCHED;
        }
        if (wr == 0) PG8_BAR;
        if constexpr (SPLIT2) {
            const bool fin = PG8_HALF(ui) == 1;
            if (fin) E(acc, cur, wr, wc, fr, fq);
            if (fin && !has_next) break;
            float fs[8]; E.scales(fs, cur, fin, wr, fr);
#pragma unroll
            for (int a = 0; a < 2; ++a)
#pragma unroll
                for (int b = 0; b < 2; ++b)
#pragma unroll
                    for (int m = 0; m < 4; ++m)
#pragma unroll
                        for (int n = 0; n < 2; ++n) acc[a][b][m][n] *= fs[a * 4 + m];
        } else {
        E(acc, cur, wr, wc, fr, fq);
        if (!has_next) break;
#pragma unroll
        for (int a = 0; a < 2; ++a)
#pragma unroll
            for (int b = 0; b < 2; ++b)
#pragma unroll
                for (int m = 0; m < 4; ++m)
#pragma unroll
                    for (int n = 0; n < 2; ++n) acc[a][b][m][n] = (f32x4){0.f, 0.f, 0.f, 0.f};
        }
        cur = nxt; cA = nA; cB = nB; ++ui;
        if (wr == 1) PG8_BAR;
    }
    PG8_WAIT_V(0);
    PG8_BAR;
#undef PG8_HALF
#undef PG8_NEXT
#undef PG8_SA
#undef PG8_SB
#undef PG8_STAGE
#undef PG8_LDA
#undef PG8_LDB
#undef PG8_MMA
#undef PG8_WAIT_V
#undef PG8_WAIT_L
#undef PG8_BAR
#undef PG8_SCHED
}
}
using pg8::Unit;
typedef f32x4 AccT[2][2][4][2];

struct EpiIn {
    static constexpr int MID_T = 0;
    bf16_t* qkvu; const float* ropec; const float* ropes;
    __device__ __forceinline__ void operator()(const AccT& acc, const Unit& u, int wr, int wc, int fr, int fq) const {
        const int t = u.pn >> 1;
        bf16_t* base = qkvu + (size_t)t * M * DH;
        const int col0 = (u.pn & 1) * 256 + wc * 32 + 8 * fq;
        const bool rope = (t < 2) && ((wc & 1) == 0);
#pragma unroll
        for (int ai = 0; ai < 2; ++ai)
#pragma unroll
            for (int m = 0; m < 4; ++m) {
                const int row = u.pm * 256 + ai * 128 + wr * 64 + m * 16 + fr;
                f32x4 v[2][2];
#pragma unroll
                for (int bj = 0; bj < 2; ++bj)
#pragma unroll
                    for (int n = 0; n < 2; ++n) v[bj][n] = acc[ai][bj][m][n];
                if (rope) {
                    const int pos = row_pos(row);
#pragma unroll
                    for (int n = 0; n < 2; ++n) {
                        const f32x4 c4 = *(const f32x4*)(ropec + pos * 8 + 4 * n), s4 = *(const f32x4*)(ropes + pos * 8 + 4 * n);
#pragma unroll
                        for (int bj = 0; bj < 2; ++bj) {
                            f32x4 o;
#pragma unroll
                            for (int e = 0; e < 4; ++e) o[e] = __shfl_xor(v[bj][n][e], 16);
                            const f32x4 r0 = v[bj][n] * c4 - o * s4, r1 = v[bj][n] * c4 + o * s4;
                            if (fq == 0) v[bj][n] = r0; else if (fq == 1) v[bj][n] = r1;
                        }
                    }
                }
#pragma unroll
                for (int bj = 0; bj < 2; ++bj) {
                    u32x4 w; w.x = cvt_pk_bf16(v[bj][0][0], v[bj][0][1]); w.y = cvt_pk_bf16(v[bj][0][2], v[bj][0][3]); w.z = cvt_pk_bf16(v[bj][1][0], v[bj][1][1]); w.w = cvt_pk_bf16(v[bj][1][2], v[bj][1][3]);
                    const int col = col0 + bj * 128;
                    if (t == 3) *(u32x4*)(base + ((size_t)(col >> 4) * M + row) * 16 + (col & 15)) = w;
                    else *(u32x4*)(base + (size_t)row * DH + col) = w;
                }
            }
    }
};
struct EpiGlu {
    static constexpr int MID_T = 0;
    const bf16_t* spre; bf16_t* mix; const float* bglu; float* ssq_s;
    __device__ __forceinline__ void operator()(const AccT& acc, const Unit& u, int wr, int wc, int fr, int fq) const {
        const int col0 = u.pn * 256 + wc * 32 + 8 * fq;
#pragma unroll
        for (int ai = 0; ai < 2; ++ai)
#pragma unroll
            for (int m = 0; m < 4; ++m) {
                const int row = u.pm * 256 + ai * 128 + wr * 64 + m * 16 + fr; float ss = 0.f;
#pragma unroll
                for (int bj = 0; bj < 2; ++bj) {
                    const int col = col0 + bj * 128;
                    const u32x4 sv = *(const u32x4*)(spre + ((size_t)(col >> 4) * M + row) * 16 + (col & 15));
                    const f32x4 b0 = *(const f32x4*)(bglu + col), b1 = *(const f32x4*)(bglu + col + 4);
                    const f32x4 z0 = acc[ai][bj][m][0] + b0, z1 = acc[ai][bj][m][1] + b1;
                    float o[8];
                    o[0] = bf_lo(sv.x) * sigmoidf_(z0[0]); o[1] = bf_hi(sv.x) * sigmoidf_(z0[1]); o[2] = bf_lo(sv.y) * sigmoidf_(z0[2]); o[3] = bf_hi(sv.y) * sigmoidf_(z0[3]);
                    o[4] = bf_lo(sv.z) * sigmoidf_(z1[0]); o[5] = bf_hi(sv.z) * sigmoidf_(z1[1]); o[6] = bf_lo(sv.w) * sigmoidf_(z1[2]); o[7] = bf_hi(sv.w) * sigmoidf_(z1[3]);
#pragma unroll
                    for (int e = 0; e < 8; ++e) ss += o[e] * o[e];
                    u32x4 w; w.x = cvt_pk_bf16(o[0], o[1]); w.y = cvt_pk_bf16(o[2], o[3]); w.z = cvt_pk_bf16(o[4], o[5]); w.w = cvt_pk_bf16(o[6], o[7]);
                    *(u32x4*)(mix + (size_t)row * D + DH + col) = w;
                }
                ss += __shfl_xor(ss, 16); ss += __shfl_xor(ss, 32);
                if (fq == 0) atomicAdd(ssq_s + row, ss);
                asm volatile("" ::: "memory");
            }
    }
};
struct EpiOut {
    static constexpr int MID_T = 8;
    const float* xp; const float* xs; float* out; bf16_t* y1b; const float* ssq_a; const float* ssq_s; float* ln_sum; float* ln_sq;
    __device__ __forceinline__ void scales(float (&fs)[8], const Unit& u, bool fin, int wr, int fr) const {
#pragma unroll
        for (int i = 0; i < 8; ++i) {
            const int row = u.pm * 256 + (i >> 2) * 128 + wr * 64 + (i & 3) * 16 + fr;
            const float va = ssq_a[row] * (1.0f / DH) + LN_EPS, vs = ssq_s[row] * (1.0f / DH) + LN_EPS;
            const float f = __builtin_amdgcn_sqrtf(vs * fast_rcp(va));
            fs[i] = fin ? 0.f : f;
        }
    }
    __device__ __forceinline__ void operator()(const AccT& acc, const Unit& u, int wr, int wc, int fr, int fq) const {
        const int col0 = u.pn * 256 + wc * 32 + 8 * fq;
        const float* xb = (u.pm < MP / 256) ? xp : xs - (size_t)MP * D;
#pragma unroll
        for (int ai = 0; ai < 2; ++ai)
#pragma unroll
            for (int m = 0; m < 4; ++m) {
                const int row = u.pm * 256 + ai * 128 + wr * 64 + m * 16 + fr;
                const float rs = __builtin_amdgcn_rsqf(ssq_s[row] * (1.0f / DH) + LN_EPS);
                const size_t ro = (size_t)row * D + col0;
                float s1 = 0.f, s2 = 0.f;
#pragma unroll
                for (int bj = 0; bj < 2; ++bj) {
                    const size_t o = ro + bj * 128;
                    const f32x4 x0 = *(const f32x4*)(xb + o), x1 = *(const f32x4*)(xb + o + 4);
                    const f32x4 y0 = x0 * DN_ALPHA + acc[ai][bj][m][0] * rs, y1 = x1 * DN_ALPHA + acc[ai][bj][m][1] * rs;
                    s1 += ((y0[0] + y0[1]) + (y0[2] + y0[3])) + ((y1[0] + y1[1]) + (y1[2] + y1[3]));
                    s2 += ((y0[0] * y0[0] + y0[1] * y0[1]) + (y0[2] * y0[2] + y0[3] * y0[3])) + ((y1[0] * y1[0] + y1[1] * y1[1]) + (y1[2] * y1[2] + y1[3] * y1[3]));
                    *(u32x4*)(y1b + o) = (u32x4){cvt_pk_bf16(y0[0], y0[1]), cvt_pk_bf16(y0[2], y0[3]), cvt_pk_bf16(y1[0], y1[1]), cvt_pk_bf16(y1[2], y1[3])};
                }
                s1 += __shfl_xor(s1, 16); s1 += __shfl_xor(s1, 32); s2 += __shfl_xor(s2, 16); s2 += __shfl_xor(s2, 32);
                if (fq < 2) atomicAdd((fq == 0 ? ln_sum : ln_sq) + row, fq == 0 ? s1 : s2);
                asm volatile("" ::: "memory");
            }
    }
};
struct EpiUp {
    static constexpr int MID_T = 0;
    bf16_t* f; const float* gW; const float* bW; const float* convw; const float* convb; const float* ln_sum; const float* ln_sq;
    __device__ __forceinline__ void operator()(const AccT& acc, const Unit& u, int wr, int wc, int fr, int fq) const {
        const int feat0 = u.pn * 128 + wc * 32 + 8 * fq;
        const int pc0 = u.pn * 256 + wc * 32 + 8 * fq;
        const int rbase = u.pm * UP_TM + wr * 126 - 1 + 8 * fr;
        float ra[8], rb[8];
        unsigned vmask = 0, pmask = 0, nmask = 0;
        float sm[8], sq[8];
        {
            const f32x4 a0 = *(const f32x4u*)(ln_sum + rbase), a1 = *(const f32x4u*)(ln_sum + rbase + 4), b0 = *(const f32x4u*)(ln_sq + rbase), b1 = *(const f32x4u*)(ln_sq + rbase + 4);
#pragma unroll
            for (int e = 0; e < 4; ++e) { sm[e] = a0[e]; sm[4 + e] = a1[e]; sq[e] = b0[e]; sq[4 + e] = b1[e]; }
        }
#pragma unroll
        for (int i = 0; i < 8; ++i) {
            const int lr = 8 * fr + i;
            const int rowu = rbase + i; const int row = rowu < 0 ? 0 : (rowu >= M ? M - 1 : rowu);
            const float mu = sm[i] * (1.0f / D), var = fmaxf(sq[i] * (1.0f / D) - mu * mu, 0.f), rstd = __builtin_amdgcn_rsqf(var + LN_EPS);
            ra[i] = rstd; rb[i] = -rstd * mu;
            const int pos = row_pos(row), sl = row_slen(row);
            if ((lr >= 1) && (lr <= 126) && (rowu >= 0) && (rowu < M)) vmask |= 1u << i;
            if (pos != 0) pmask |= 1u << i;
            if (pos != sl - 1) nmask |= 1u << i;
        }
        const bool anyedge = __builtin_amdgcn_ballot_w64((pmask & nmask) != 0xffu) != 0ull;
        const float C1 = -2.0f * 0.7978845608028654f * 1.4426950408889634f, C2 = C1 * 0.044715f;
        u32x2 stash[8];
#pragma unroll
        for (int n = 0; n < 2; ++n) {
            const f32x4 gWg = *(const f32x4*)(gW + pc0 + 4 * n), bWg = *(const f32x4*)(bW + pc0 + 4 * n), gWv = *(const f32x4*)(gW + pc0 + 128 + 4 * n), bWv = *(const f32x4*)(bW + pc0 + 128 + 4 * n);
            const f32x4 w0 = *(const f32x4*)(convw + feat0 + 4 * n), w1 = *(const f32x4*)(convw + FF + feat0 + 4 * n), w2 = *(const f32x4*)(convw + 2 * FF + feat0 + 4 * n), cb = *(const f32x4*)(convb + feat0 + 4 * n);
#define GATE(i) (acc[(i) >> 2][0][(i) & 3][n] * ra[i] + (gWg * rb[i] + bWg))
            const f32x4 g0 = GATE(0), g7 = GATE(7);
            f32x4 gp, nlast;
#pragma unroll
            for (int e = 0; e < 4; ++e) { gp[e] = dpp_f<0x121>(g7[e]); nlast[e] = dpp_f<0x12F>(g0[e]); }
            f32x4 gc = g0;
#pragma unroll
            for (int i = 0; i < 8; ++i) {
                f32x4 gn = nlast;
                if (i < 6) gn = GATE(i + 1); else if (i == 6) gn = g7;
                const f32x4 val = acc[i >> 2][1][i & 3][n] * ra[i] + (gWv * rb[i] + bWv);
                f32x4 pv = gp, nv = gn;
                if (anyedge) { if (!((pmask >> i) & 1u)) pv = (f32x4){0.f, 0.f, 0.f, 0.f}; if (!((nmask >> i) & 1u)) nv = (f32x4){0.f, 0.f, 0.f, 0.f}; }
                const f32x4 cv = w0 * pv + (w1 * gc + (w2 * nv + cb));
                const f32x4 tt = cv * (cv * cv * C2 + C1);
                f32x4 o;
#pragma unroll
                for (int e = 0; e < 4; ++e) o[e] = cv[e] * fast_rcp(1.0f + fast_exp2(tt[e])) * val[e];
                const u32x2 pk = (u32x2){cvt_pk_bf16(o[0], o[1]), cvt_pk_bf16(o[2], o[3])};
                if (n == 0) stash[i] = pk;
                else if ((vmask >> i) & 1u) *(u32x4*)(f + (size_t)(rbase + i) * FF + feat0) = (u32x4){stash[i].x, stash[i].y, pk.x, pk.y};
                gp = gc; gc = gn;
            }
#undef GATE
        }
    }
};
struct EpiDown {
    static constexpr int MID_T = 0;
    const bf16_t* y1b; bf16_t* y2b; const float* g1; const float* b1; const float* ln1_sum; const float* ln1_sq; float* ln2_sum; float* ln2_sq;
    __device__ __forceinline__ void operator()(const AccT& acc, const Unit& u, int wr, int wc, int fr, int fq) const {
        const int col0 = u.pn * 256 + wc * 32 + 8 * fq;
#pragma unroll
        for (int ai = 0; ai < 2; ++ai)
#pragma unroll
            for (int m = 0; m < 4; ++m) {
                const int row = u.pm * 256 + ai * 128 + wr * 64 + m * 16 + fr;
                const float mu = ln1_sum[row] * (1.0f / D), var = ln1_sq[row] * (1.0f / D) - mu * mu, rstd = __builtin_amdgcn_rsqf(var + LN_EPS);
                float s1 = 0.f, s2 = 0.f;
#pragma unroll
                for (int bj = 0; bj < 2; ++bj) {
                    const int col = col0 + bj * 128;
                    const u32x4 yv = *(const u32x4*)(y1b + (size_t)row * D + col);
                    const f32x4 ya = (f32x4){bf_lo(yv.x), bf_hi(yv.x), bf_lo(yv.y), bf_hi(yv.y)}, yb = (f32x4){bf_lo(yv.z), bf_hi(yv.z), bf_lo(yv.w), bf_hi(yv.w)};
                    const f32x4 ga = *(const f32x4*)(g1 + col), gb = *(const f32x4*)(g1 + col + 4), ba = *(const f32x4*)(b1 + col), bb = *(const f32x4*)(b1 + col + 4);
                    const f32x4 za = ((ya - mu) * rstd * ga + ba) * DN_ALPHA + acc[ai][bj][m][0], zb = ((yb - mu) * rstd * gb + bb) * DN_ALPHA + acc[ai][bj][m][1];
#pragma unroll
                    for (int e = 0; e < 4; ++e) { s1 += za[e] + zb[e]; s2 += za[e] * za[e] + zb[e] * zb[e]; }
                    u32x4 w; w.x = cvt_pk_bf16(za[0], za[1]); w.y = cvt_pk_bf16(za[2], za[3]); w.z = cvt_pk_bf16(zb[0], zb[1]); w.w = cvt_pk_bf16(zb[2], zb[3]);
                    *(u32x4*)(y2b + (size_t)row * D + col) = w;
                }
                s1 += __shfl_xor(s1, 16); s1 += __shfl_xor(s1, 32); s2 += __shfl_xor(s2, 16); s2 += __shfl_xor(s2, 32);
                if (fq < 2) atomicAdd((fq == 0 ? ln2_sum : ln2_sq) + row, fq == 0 ? s1 : s2);
                asm volatile("" ::: "memory");
            }
    }
};

__device__ __forceinline__ unsigned f2bf(float f) { unsigned u = __float_as_uint(f); return (u + 0x7fffu + ((u >> 16) & 1u)) >> 16; }
__device__ __forceinline__ unsigned pk2(float lo, float hi) { return f2bf(lo) | (f2bf(hi) << 16); }
template <int UPMAP>
__device__ __forceinline__ void p0_transpose_item(const float* W, int K, int N, bf16_t* WT, const float* ks, const float* ks2, LAS float* scr, int item, int lane) {
    const int nblk = N / 32, kb = item / nblk, nb = item % nblk, k0 = 64 * kb, n0 = 32 * nb;
#pragma unroll 8
    for (int i = 0; i < 32; ++i) { const int kk = 2 * i + (lane >> 5); float sc = 1.0f; if (ks) { const int kg = k0 + kk; sc = (ks2 && kg >= DH) ? ks2[kg - DH] : ks[kg]; }
        scr[kk * 33 + (lane & 31)] = W[(size_t)(k0 + kk) * N + n0 + (lane & 31)] * sc; }
    asm volatile("s_waitcnt lgkmcnt(0)" ::: "memory");
    const int c = lane & 7;
#pragma unroll
    for (int j = 0; j < 4; ++j) { const int n = (lane >> 3) + 8 * j; const LAS float* s = scr + (8 * c) * 33 + n;
        u32x4 o; o.x = pk2(s[0 * 33], s[1 * 33]); o.y = pk2(s[2 * 33], s[3 * 33]); o.z = pk2(s[4 * 33], s[5 * 33]); o.w = pk2(s[6 * 33], s[7 * 33]);
        int ng = n0 + n;
        if (UPMAP) { const int isv = ng >= FF, ft = isv ? ng - FF : ng; ng = 256 * (ft >> 7) + 128 * isv + (ft & 127); }
        *(u32x4*)(WT + (size_t)ng * K + k0 + 8 * c) = o; }
    asm volatile("s_waitcnt lgkmcnt(0)" ::: "memory");
}

__device__ __forceinline__ void p0_prep(KP P, LAS unsigned char* lds, int gw, int NGW, int lane) {
    unsigned char* ws = P->ws;
    const int wave = threadIdx.x >> 6;
    LAS float* scr = (LAS float*)(lds + wave * 16384);
    constexpr int I_IN = (D / 64) * (NIN / 32), I_GLU = (DH / 64) * (DH / 32), I_OUT = (D / 64) * (D / 32), I_UP = (D / 64) * (NUP / 32), I_DN = (FF / 64) * (D / 32);
    constexpr int NITEMS = I_IN + I_GLU + I_OUT + I_UP + I_DN;
    for (int it = gw; it < NITEMS; it += NGW) {
        int r = it;
        if (r < I_IN) { p0_transpose_item<0>(P->in[2], D, NIN, (bf16_t*)(ws + WS_WIN), nullptr, nullptr, scr, r, lane); continue; } r -= I_IN;
        if (r < I_GLU) { p0_transpose_item<0>(P->in[12], DH, DH, (bf16_t*)(ws + WS_WGLU), nullptr, nullptr, scr, r, lane); continue; } r -= I_GLU;
        if (r < I_OUT) { p0_transpose_item<0>(P->in[15], D, D, (bf16_t*)(ws + WS_WOUT), P->in[3], P->in[14], scr, r, lane); continue; } r -= I_OUT;
        if (r < I_UP) { p0_transpose_item<1>(P->in[18], D, NUP, (bf16_t*)(ws + WS_WUP), P->in[16], nullptr, scr, r, lane); continue; } r -= I_UP;
        p0_transpose_item<0>(P->in[21], FF, D, (bf16_t*)(ws + WS_WDN), nullptr, nullptr, scr, r, lane);
    }
    const int gt = gw * 64 + lane, NGT = NGW * 64;
    for (int it = gw; it < NUP / 4; it += NGW) {
        const float* w = P->in[18]; const float* g = P->in[16]; const float* b = P->in[17];
        const int n = it * 4 + (lane >> 4), kseg = lane & 15;
        float sg = 0.f, sb = 0.f;
#pragma unroll 8
        for (int kk = 0; kk < 64; ++kk) { const int k = kseg * 64 + kk; const float wv = w[(size_t)k * NUP + n]; sg += __uint_as_float(f2bf(g[k] * wv) << 16); sb += b[k] * wv; }
#pragma unroll
        for (int o = 1; o < 16; o <<= 1) { sg += __shfl_xor(sg, o); sb += __shfl_xor(sb, o); }
        if (kseg == 0) { const int isv = n >= FF, ft = isv ? n - FF : n, pc = 256 * (ft >> 7) + 128 * isv + (ft & 127);
            ((float*)(ws + WS_GW))[pc] = sg; ((float*)(ws + WS_BW))[pc] = sb; }
    }
    for (int i = gt; i < 6 * M / 4; i += NGT) ((f32x4*)(ws + WS_STATS))[i] = (f32x4){0.f, 0.f, 0.f, 0.f};
    for (int i = gt; i < 16384 * 8; i += NGT) {
        const int pos = i >> 3, j = i & 7;
        const double invf[8] = {1.0, 0.19392274474868576, 0.03760603093086393, 0.007292664737217109, 0.001414213562373095, 0.0002742481756762073, 5.318295896944988e-05, 1.031338537721246e-05};
        double fr_ = 1.0;
#pragma unroll
        for (int q = 0; q < 8; ++q) fr_ = (j == q) ? invf[q] : fr_;
        const double ang = (double)pos * fr_;
        const double k2 = rint(ang * 0.15915494309189535);
        const double red = fma(-k2, 6.283185307179586, ang) - k2 * 2.4492935982947064e-16;
        float sn, cs; sincosf((float)red, &sn, &cs);
        ((float*)(ws + WS_ROPEC))[i] = cs; ((float*)(ws + WS_ROPES))[i] = sn;
    }
    for (int i = gt; i < 2 * 32 * 64; i += NGT) {
        const int dg = i >> 6;
        const double dt = exp((double)P->in[6][dg]);
        const double are = P->in[4][i], aim = P->in[5][i];
        const double mag = exp(are * dt), ang = aim * dt;
        double lr = mag * cos(ang), li = mag * sin(ang);
        ((f32x2*)(ws + WS_LAM))[i] = (f32x2){(float)lr, (float)li};
        for (int q = 0; q < 5; ++q) { const double t = lr * lr - li * li; li = 2.0 * lr * li; lr = t; }
        ((f32x2*)(ws + WS_LAML))[i] = (f32x2){(float)lr, (float)li};
    }
    for (int i = gt; i < 2 * 32 * 8 * 64; i += NGT) {
        const int ln = i & 63, T = (i >> 6) & 7, dg = i >> 9;
        const int s = T >> 1, ri = T & 1, p = 16 * s + (ln & 15), q = ln >> 4;
        const double dt = exp((double)P->in[6][dg]);
        const double are = P->in[4][dg * 64 + p], aim = P->in[5][dg * 64 + p];
        const double mag = exp(are * dt), ang = aim * dt;
        const double lr = mag * cos(ang) - 1.0, li = mag * sin(ang);
        const double den = are * are + aim * aim;
        const double cr = (lr * are + li * aim) / den, ci = (li * are - lr * aim) / den;
        unsigned short v[8];
#pragma unroll
        for (int j = 0; j < 8; ++j) { const int c = 4 * q + (j & 3); const size_t bi = ((size_t)dg * 64 + p) * 16 + c;
            const double br = P->in[7][bi], bim = P->in[8][bi];
            const double o = ri == 0 ? (cr * br - ci * bim) : (cr * bim + ci * br);
            v[j] = j < 4 ? (unsigned short)f2bf((float)o) : (unsigned short)0; }
        ((u32x4*)(ws + WS_BFRAG))[i] = (u32x4){(unsigned)v[0] | ((unsigned)v[1] << 16), (unsigned)v[2] | ((unsigned)v[3] << 16), (unsigned)v[4] | ((unsigned)v[5] << 16), (unsigned)v[6] | ((unsigned)v[7] << 16)};
    }
    for (int i = gt; i < 32 * 5 * 64; i += NGT) {
        const int ln = i & 63, kb = (i >> 6) % 5, g = i / 320;
        const int ch = ln & 15, q = ln >> 4;
        unsigned short v[8];
#pragma unroll
        for (int jj = 0; jj < 8; ++jj) {
            if (kb < 4) { const int p = 16 * kb + 4 * q + (jj & 3); const size_t ci = ((size_t)g * 16 + ch) * 64 + p; v[jj] = (unsigned short)f2bf(jj < 4 ? P->in[9][ci] : -P->in[10][ci]); }
            else { const int c2 = 4 * q + (jj & 3); const float dv = P->in[11][g * 16 + ch]; const unsigned hi = f2bf(dv); const float lo = dv - __uint_as_float(hi << 16);
                   v[jj] = (c2 == ch) ? (unsigned short)(jj < 4 ? hi : f2bf(lo)) : (unsigned short)0; }
        }
        ((u32x4*)(ws + WS_CFRAG))[i] = (u32x4){(unsigned)v[0] | ((unsigned)v[1] << 16), (unsigned)v[2] | ((unsigned)v[3] << 16), (unsigned)v[4] | ((unsigned)v[5] << 16), (unsigned)v[6] | ((unsigned)v[7] << 16)};
    }
    for (size_t i = gt; i < (size_t)M * D / 8; i += NGT) {
        const size_t e = i * 8; const float* src = e < (size_t)MP * D ? P->in[0] + e : P->in[1] + (e - (size_t)MP * D);
        const f32x4 a = *(const f32x4*)src, b = *(const f32x4*)(src + 4);
        u32x4 w; w.x = cvt_pk_bf16(a[0], a[1]); w.y = cvt_pk_bf16(a[2], a[3]); w.z = cvt_pk_bf16(b[0], b[1]); w.w = cvt_pk_bf16(b[2], b[3]);
        ((u32x4*)(ws + WS_XB))[i] = w;
    }
}

constexpr int VROW = 144;
constexpr int ATT_ML = 131072;
struct AttBuf { bf16x8 kf[2][2]; u32x4 vreg[4]; };
__device__ __forceinline__ unsigned att_po(int t) { return (unsigned)((t >> 6) * 16384 + 8192 + (t & 63) * 128); }
template <int TYPE> __device__ __forceinline__ void att_step_params(int s, int i0, int t0, int& sh, int& mb) {
    if (TYPE == 0) { sh = s >= 5 ? 2 : 4; mb = s >= 5 ? (4 * i0 - 64 + 32 * (s - 5)) : (i0 - 64 + 32 * s); }
    else { sh = 0; mb = t0 - 64 + 32 * s; }
}
__device__ __forceinline__ void att_load(AttBuf& B, const bf16_t* __restrict__ Kt, const bf16_t* __restrict__ Vt, int sh, int mb, int r, int S, int sbrow, int h, int lane) {
    const int qi = lane & 15, g4 = lane >> 4;
    const int tlo = r + (mb << sh), thi = r + ((mb + 31) << sh);
    if (tlo >= 0 && thi < S) {
        const size_t ub = ((size_t)(sbrow + tlo) * DH + h * 64) * 2;
        const char* kb = (const char*)Kt + ub; const char* vb = (const char*)Vt + ub;
        const unsigned lk = (unsigned)(((qi << sh) * DH + 8 * g4) * 2), lv = (unsigned)((((lane >> 3) << sh) * DH + 8 * (lane & 7)) * 2);
        const unsigned bstep = (unsigned)((16 << sh) * DH * 2), vstep = (unsigned)((8 << sh) * DH * 2);
#pragma unroll
        for (int blk = 0; blk < 2; ++blk) { B.kf[blk][0] = *(const bf16x8*)(kb + blk * bstep + lk); B.kf[blk][1] = *(const bf16x8*)(kb + blk * bstep + lk + 64); }
#pragma unroll
        for (int i = 0; i < 4; ++i) B.vreg[i] = *(const u32x4*)(vb + i * vstep + lv);
    } else {
#pragma unroll
        for (int blk = 0; blk < 2; ++blk) {
            int tok = r + ((mb + 16 * blk + qi) << sh); tok = tok < 0 ? 0 : (tok >= S ? S - 1 : tok);
            const bf16_t* kp = Kt + (size_t)(sbrow + tok) * DH + h * 64 + 8 * g4;
            B.kf[blk][0] = *(const bf16x8*)kp; B.kf[blk][1] = *(const bf16x8*)(kp + 32);
        }
#pragma unroll
        for (int i = 0; i < 4; ++i) { const int idx = lane + 64 * i, rw = idx >> 3, ch = idx & 7;
            int tok = r + ((mb + rw) << sh); tok = tok < 0 ? 0 : (tok >= S ? S - 1 : tok);
            B.vreg[i] = *(const u32x4*)(Vt + (size_t)(sbrow + tok) * DH + h * 64 + 8 * ch); }
    }
}
__device__ __forceinline__ void att_comp(const AttBuf& B, const bf16x8 (&qf0)[2], f32x4 (&O)[2][4], float (&mrun)[2], float (&lsum)[2], LAS unsigned char* vl, unsigned vrd,
                                         int sh, int mb, int r, int S, int qp0, int qstep, int lane) {
    const int qi = lane & 15, g4 = lane >> 4;
    const float SC = 0.125f * 1.4426950408889634f;
#pragma unroll
    for (int i = 0; i < 4; ++i) { const int idx = lane + 64 * i, rw = idx >> 3, ch = idx & 7; *(LAS u32x4*)(vl + rw * VROW + ch * 16) = B.vreg[i]; }
    const int tlo = r + (mb << sh), thi = r + ((mb + 31) << sh);
    const bool edge = (tlo < 0) || (thi >= S);
    bf16x8 pf[2];
#pragma unroll
    for (int gq = 0; gq < 2; ++gq) {
        const int qg0 = qp0 + 16 * gq * qstep;
        if ((mb > qg0 + 15 * qstep + 64) || (mb + 31 < qg0 - 64)) { pf[gq] = (bf16x8){0, 0, 0, 0, 0, 0, 0, 0}; continue; }
        f32x4 sa[2];
        bf16x8 q0 = qf0[0], q1 = qf0[1];
        if (gq == 1) { q0 = *(const LAS bf16x8*)(vl + 4608 + lane * 16); q1 = *(const LAS bf16x8*)(vl + 4608 + 1024 + lane * 16); }
#pragma unroll
        for (int blk = 0; blk < 2; ++blk) {
            sa[blk] = __builtin_amdgcn_mfma_f32_16x16x32_bf16(B.kf[blk][0], q0, (f32x4){0.f, 0.f, 0.f, 0.f}, 0, 0, 0);
            sa[blk] = __builtin_amdgcn_mfma_f32_16x16x32_bf16(B.kf[blk][1], q1, sa[blk], 0, 0, 0);
        }
        const bool band = (mb < qg0 + 15 * qstep - 64) || (mb + 31 > qg0 + 64);
        float sv[8]; float mx;
        if (edge || band) {
            const int dbase = mb + 4 * g4 - (qg0 + qi * qstep) + 64;
            mx = -INFINITY;
#pragma unroll
            for (int blk = 0; blk < 2; ++blk)
#pragma unroll
                for (int j = 0; j < 4; ++j) {
                    bool ok = (unsigned)(dbase + 16 * blk + j) <= 128u;
                    if (edge) { const int tk = r + ((mb + 16 * blk + 4 * g4 + j) << sh); ok = ok && (tk >= 0) && (tk < S); }
                    const float x = ok ? sa[blk][j] : -INFINITY;
                    sv[blk * 4 + j] = x; mx = fmaxf(mx, x);
                }
        } else {
#pragma unroll
            for (int e = 0; e < 8; ++e) sv[e] = sa[e >> 2][e & 3];
            mx = fmaxf(fmaxf(fmaxf(sv[0], sv[1]), fmaxf(sv[2], sv[3])), fmaxf(fmaxf(sv[4], sv[5]), fmaxf(sv[6], sv[7])));
        }
        mx = fmaxf(mx, __shfl_xor(mx, 16)); mx = fmaxf(mx, __shfl_xor(mx, 32));
        const float mnew = fmaxf(mrun[gq], mx * SC);
        if (__builtin_amdgcn_ballot_w64(mnew > mrun[gq]) != 0ull) {
            const float alpha = fast_exp2(mrun[gq] - mnew);
            lsum[gq] *= alpha;
#pragma unroll
            for (int db = 0; db < 4; ++db) O[gq][db] *= alpha;
            mrun[gq] = mnew;
        }
        float p[8]; float ps = 0.f;
#pragma unroll
        for (int e = 0; e < 8; ++e) { p[e] = fast_exp2(sv[e] * SC - mrun[gq]); ps += p[e]; }
        lsum[gq] += ps;
        const u32x4 w = (u32x4){cvt_pk_bf16(p[0], p[1]), cvt_pk_bf16(p[2], p[3]), cvt_pk_bf16(p[4], p[5]), cvt_pk_bf16(p[6], p[7])}; pf[gq] = __builtin_bit_cast(bf16x8, w);
    }
#pragma unroll
    for (int db = 0; db < 4; ++db) {
        typedef short v4i16_t __attribute__((ext_vector_type(4)));
        const v4i16_t lo = __builtin_amdgcn_ds_read_tr16_b64_v4i16((LAS v4i16_t*)(vl + vrd + db * 32));
        const v4i16_t hi = __builtin_amdgcn_ds_read_tr16_b64_v4i16((LAS v4i16_t*)(vl + vrd + 16 * VROW + db * 32));
        const bf16x8 vf = (bf16x8){lo[0], lo[1], lo[2], lo[3], hi[0], hi[1], hi[2], hi[3]};
        O[0][db] = __builtin_amdgcn_mfma_f32_16x16x32_bf16(vf, pf[0], O[0][db], 0, 0, 0);
        O[1][db] = __builtin_amdgcn_mfma_f32_16x16x32_bf16(vf, pf[1], O[1][db], 0, 0, 0);
    }
}
template <int TYPE>
__device__ __forceinline__ void attn_tile(const bf16_t* __restrict__ Q, const bf16_t* __restrict__ Kt, const bf16_t* __restrict__ Vt, bf16_t* mix, float* ssq_a,
                                          LAS unsigned char* lds, LAS unsigned char* vl, int bb, int h, int idx, int lane) {
    constexpr int NS = TYPE == 0 ? 13 : 5;
    const int row0 = bb * 512;
    const int pos0 = row_pos(row0), S = row_slen(row0), sbrow = row0 - pos0;
    const int i0 = pos0 >> 4, t0 = pos0 + 32 * idx;
    const int qi = lane & 15, g4 = lane >> 4;
    const int r = TYPE == 0 ? idx : 0;
    int tq[2];
    bf16x8 qf[2];
#pragma unroll
    for (int gq = 0; gq < 2; ++gq) {
        tq[gq] = TYPE == 0 ? idx + 16 * (i0 + qi + 16 * gq) : t0 + qi + 16 * gq;
#pragma unroll
        for (int kk = 0; kk < 2; ++kk) { const bf16x8 qv = *(const bf16x8*)(Q + (size_t)(sbrow + tq[gq]) * DH + h * 64 + 32 * kk + 8 * g4);
            if (gq == 0) qf[kk] = qv; else *(LAS bf16x8*)(vl + 4608 + kk * 1024 + lane * 16) = qv; }
    }
    f32x4 O[2][4];
#pragma unroll
    for (int gq = 0; gq < 2; ++gq)
#pragma unroll
        for (int db = 0; db < 4; ++db) O[gq][db] = (f32x4){0.f, 0.f, 0.f, 0.f};
    float mrun[2] = {-1e30f, -1e30f}, lsum[2] = {0.f, 0.f};
    const unsigned vrd = (unsigned)((4 * g4 + ((lane & 15) >> 2)) * VROW + (lane & 3) * 8);
    AttBuf B0, B1, B2;
#define ATT_LOAD(B, s) do { int sh_, mb_; att_step_params<TYPE>((s), i0, t0, sh_, mb_); att_load(B, Kt, Vt, sh_, mb_, r, S, sbrow, h, lane); } while (0)
#define ATT_COMP(B, s) do { int sh_, mb_; att_step_params<TYPE>((s), i0, t0, sh_, mb_); \
        const int qstep_ = TYPE == 0 ? (16 >> sh_) : 1, qp0_ = TYPE == 0 ? qstep_ * i0 : t0; \
        att_comp(B, qf, O, mrun, lsum, vl, vrd, sh_, mb_, r, S, qp0_, qstep_, lane); } while (0)
    ATT_LOAD(B0, 0); ATT_LOAD(B1, 1);
    int s = 0;
#pragma unroll 1
    for (; s + 3 <= NS; s += 3) {
        if (s + 2 < NS) ATT_LOAD(B2, s + 2);
        ATT_COMP(B0, s);
        if (s + 3 < NS) ATT_LOAD(B0, s + 3);
        ATT_COMP(B1, s + 1);
        if (s + 4 < NS) ATT_LOAD(B1, s + 4);
        ATT_COMP(B2, s + 2);
    }
    if (NS % 3 >= 1) ATT_COMP(B0, s);
    if (NS % 3 >= 2) ATT_COMP(B1, s + 1);
#undef ATT_LOAD
#undef ATT_COMP
#pragma unroll
    for (int gq = 0; gq < 2; ++gq) {
        float ls = lsum[gq]; ls += __shfl_xor(ls, 16); ls += __shfl_xor(ls, 32);
        const int tb = tq[gq] - pos0;
        const unsigned po = att_po(tb), swz = (unsigned)((tb ^ (tb >> 4)) & 15);
        if (TYPE == 1) {
#pragma unroll
            for (int db = 0; db < 4; ++db) *(LAS u32x2*)(lds + po + (((unsigned)(4 * db + g4) ^ swz) << 3)) = (u32x2){cvt_pk_bf16(O[gq][db][0], O[gq][db][1]), cvt_pk_bf16(O[gq][db][2], O[gq][db][3])};
            if (g4 == 0) *(LAS f32x2*)(lds + ATT_ML + tb * 8) = (f32x2){mrun[gq], ls};
        } else {
            const f32x2 ml = *(const LAS f32x2*)(lds + ATT_ML + tb * 8);
            const float mm = fmaxf(mrun[gq], ml.x), ca = fast_exp2(mrun[gq] - mm), cb = fast_exp2(ml.x - mm);
            const float inv = 1.0f / (ls * ca + ml.y * cb);
            const float fa = ca * inv, fb = cb * inv;
            float ss = 0.f;
            bf16_t* orow = mix + (size_t)(sbrow + tq[gq]) * D + h * 64 + 4 * g4;
#pragma unroll
            for (int db = 0; db < 4; ++db) {
                const u32x2 obw = *(const LAS u32x2*)(lds + po + (((unsigned)(4 * db + g4) ^ swz) << 3));
                const f32x4 ob = (f32x4){bf_lo(obw.x), bf_hi(obw.x), bf_lo(obw.y), bf_hi(obw.y)};
                const f32x4 o = O[gq][db] * fa + ob * fb;
                ss += o[0] * o[0] + o[1] * o[1] + o[2] * o[2] + o[3] * o[3];
                *(u32x2*)(orow + 16 * db) = (u32x2){cvt_pk_bf16(o[0], o[1]), cvt_pk_bf16(o[2], o[3])};
            }
            ss += __shfl_xor(ss, 16); ss += __shfl_xor(ss, 32);
            if (g4 == 0) atomicAdd(ssq_a + sbrow + tq[gq], ss);
        }
    }
}

struct SsmPre { u32x2 ub[4]; float yf[4][4]; };
template <int MODE>
__device__ __forceinline__ void ssm_load(SsmPre& R, const bf16_t* __restrict__ U, const float* __restrict__ YF, unsigned uo, unsigned yo, int t0, int dir) {
    asm volatile("" : "+v"(uo), "+v"(yo));
#pragma unroll
    for (int k = 0; k < 4; ++k) {
        const unsigned tt = dir ? CL - 1 - (t0 + k) : t0 + k;
        R.ub[k] = *(const u32x2*)(U + (uo + tt * 16));
        if (MODE == 2) {
#pragma unroll
            for (int j = 0; j < 4; ++j) R.yf[k][j] = __hip_atomic_load(YF + (yo + (j * CL + tt) * 16), __ATOMIC_RELAXED, __HIP_MEMORY_SCOPE_AGENT);
        }
    }
}
template <int MODE>
__device__ __forceinline__ void ssm_task(KP P, LAS unsigned char* lw, int sbk, int g, int dir, int lane) {
    unsigned char* ws = P->ws;
    const int c = lane & 15, q = lane >> 4, dg = dir * 32 + g;
    const bf16_t* U = (const bf16_t*)(ws + WS_U);
    float* YF = (float*)(ws + WS_YF);
    f32x2* ST = (f32x2*)(ws + WS_ST);
#pragma unroll
    for (int T = 0; T < 8; ++T) *(LAS u32x4*)(lw + T * 1024 + lane * 16) = ((const u32x4*)(ws + WS_BFRAG))[(dg * 8 + T) * 64 + lane];
    f32x4 lr[4], li[4], hr[4], hi[4];
#pragma unroll
    for (int s = 0; s < 4; ++s)
#pragma unroll
        for (int j = 0; j < 4; ++j) { const f32x2 l = ((const f32x2*)(ws + WS_LAM))[dg * 64 + 16 * s + 4 * q + j]; lr[s][j] = l.x; li[s][j] = l.y; hr[s][j] = 0.f; hi[s][j] = 0.f; }
    const int chunk = sbk * 16 + c;
    const size_t stbase = ((size_t)dg * NCHUNK + chunk) * 64;
    if (MODE != 0) {
#pragma unroll
        for (int s = 0; s < 4; ++s)
#pragma unroll
            for (int j = 0; j < 4; ++j) { const f32x2 v = ST[stbase + 16 * s + 4 * q + j]; hr[s][j] = v.x; hi[s][j] = v.y; }
    }
    if (MODE != 0) {
#pragma unroll
        for (int kb = 0; kb < 5; ++kb) *(LAS u32x4*)(lw + 8192 + kb * 1024 + lane * 16) = ((const u32x4*)(ws + WS_CFRAG))[(g * 5 + kb) * 64 + lane];
    }
#define BFR(T) (*(const LAS bf16x8*)(lw + (T) * 1024 + lane * 16))
#define CFR(kb) (*(const LAS bf16x8*)(lw + 8192 + (kb) * 1024 + lane * 16))
    unsigned uo = ((unsigned)g * M + (unsigned)chunk * CL) * 16 + 4 * q;
    unsigned yo = ((unsigned)g * M + (unsigned)(sbk * 16 + 4 * q) * CL) * 16 + c;
    SsmPre R0, R1;
#define SSM_STEP(R, k, t) do { \
        if (((k) & 1) == 0) { __builtin_amdgcn_sched_barrier(0); asm volatile("" : "+v"(yo) :: "memory"); } \
        const bf16x8 ub = __builtin_bit_cast(bf16x8, ((u32x4){R.ub[k].x, R.ub[k].y, R.ub[k].x, R.ub[k].y})); \
        bf16x8 cfl[4], cf4; \
        if (MODE != 0) { _Pragma("unroll") for (int kb = 0; kb < 4; ++kb) cfl[kb] = CFR(kb); cf4 = CFR(4); } \
        f32x4 bu[8]; \
        _Pragma("unroll") for (int T = 0; T < 8; ++T) bu[T] = __builtin_amdgcn_mfma_f32_16x16x32_bf16(BFR(T), ub, (f32x4){0.f, 0.f, 0.f, 0.f}, 0, 0, 0); \
        _Pragma("unroll") for (int s = 0; s < 4; ++s) { \
            const f32x4 nr = lr[s] * hr[s] - li[s] * hi[s] + bu[2 * s], ni = lr[s] * hi[s] + li[s] * hr[s] + bu[2 * s + 1]; \
            hr[s] = nr; hi[s] = ni; } \
        if (MODE != 0) { \
            f32x4 y = (f32x4){0.f, 0.f, 0.f, 0.f}, y2 = (f32x4){0.f, 0.f, 0.f, 0.f}; \
            if (MODE == 1) y2 = __builtin_amdgcn_mfma_f32_16x16x32_bf16(ub, cf4, y2, 0, 0, 0); \
            _Pragma("unroll") for (int kb = 0; kb < 4; ++kb) { \
                const u32x4 w = (u32x4){cvt_pk_bf16(hr[kb][0], hr[kb][1]), cvt_pk_bf16(hr[kb][2], hr[kb][3]), cvt_pk_bf16(hi[kb][0], hi[kb][1]), cvt_pk_bf16(hi[kb][2], hi[kb][3])}; \
                if (kb & 1) y2 = __builtin_amdgcn_mfma_f32_16x16x32_bf16(__builtin_bit_cast(bf16x8, w), cfl[kb], y2, 0, 0, 0); \
                else y = __builtin_amdgcn_mfma_f32_16x16x32_bf16(__builtin_bit_cast(bf16x8, w), cfl[kb], y, 0, 0, 0); } \
            y += y2; \
            const unsigned tt = dir ? CL - 1 - (t) : (t); \
            _Pragma("unroll") for (int j = 0; j < 4; ++j) { \
                const unsigned oi = yo + (j * CL + tt) * 16; \
                if (MODE == 1) YF[oi] = y[j]; \
                else ((bf16_t*)(ws + WS_SPRE))[oi] = (bf16_t)(cvt_pk_bf16(gelu_tanh(y[j] + R.yf[k][j]), 0.f) & 0xffffu); } \
        } } while (0)
    SsmPre R2;
    ssm_load<MODE>(R0, U, YF, uo, yo, 0, dir);
    ssm_load<MODE>(R1, U, YF, uo, yo, 4, dir);
#define SSM_BLK(R, t0) do { SSM_STEP(R, 0, (t0)); SSM_STEP(R, 1, (t0) + 1); SSM_STEP(R, 2, (t0) + 2); SSM_STEP(R, 3, (t0) + 3); } while (0)
    ssm_load<MODE>(R2, U, YF, uo, yo, 8, dir);  SSM_BLK(R0, 0);
    ssm_load<MODE>(R0, U, YF, uo, yo, 12, dir); SSM_BLK(R1, 4);
    ssm_load<MODE>(R1, U, YF, uo, yo, 16, dir); SSM_BLK(R2, 8);
    ssm_load<MODE>(R2, U, YF, uo, yo, 20, dir); SSM_BLK(R0, 12);
    ssm_load<MODE>(R0, U, YF, uo, yo, 24, dir); SSM_BLK(R1, 16);
    ssm_load<MODE>(R1, U, YF, uo, yo, 28, dir); SSM_BLK(R2, 20);
    SSM_BLK(R0, 24);
    SSM_BLK(R1, 28);
#undef SSM_BLK
#undef SSM_STEP
#undef BFR
#undef CFR
    if (MODE == 0) {
#pragma unroll
        for (int s = 0; s < 4; ++s)
#pragma unroll
            for (int j = 0; j < 4; ++j) ST[stbase + 16 * s + 4 * q + j] = (f32x2){hr[s][j], hi[s][j]};
    }
}
__device__ __forceinline__ void ssm_carry(KP P, int gt, int NGT) {
    unsigned char* ws = P->ws; f32x2* ST = (f32x2*)(ws + WS_ST);
    for (int i = gt; i < 64 * 10 * 64; i += NGT) {
        const int p = i & 63, sq = (i >> 6) % 10, dg = i / 640, dir = dg >> 5;
        const int c0 = (sq < 2 ? sq * 16384 : MP + (sq - 2) * 8192) / CL, nc = (sq < 2 ? 16384 : 8192) / CL;
        const f32x2 L = ((const f32x2*)(ws + WS_LAML))[dg * 64 + p];
        f32x2 carry = (f32x2){0.f, 0.f};
        f32x2* base = ST + ((size_t)dg * NCHUNK + c0) * 64 + p;
        for (int k0 = 0; k0 < nc; k0 += 32) {
            f32x2 e[32];
#pragma unroll
            for (int k = 0; k < 32; ++k) { const int ck = dir ? nc - 1 - (k0 + k) : k0 + k; e[k] = base[(size_t)ck * 64]; }
#pragma unroll
            for (int k = 0; k < 32; ++k) { const int ck = dir ? nc - 1 - (k0 + k) : k0 + k; base[(size_t)ck * 64] = carry;
                const float cr = L.x * carry.x - L.y * carry.y + e[k].x, ci = L.x * carry.y + L.y * carry.x + e[k].y; carry = (f32x2){cr, ci}; }
        }
    }
}

constexpr int LDS_BYTES = 147456;
__global__ void __launch_bounds__(512, 2) mega_fwd(Params Pval, int ph_lo, int ph_hi) {
    KP P = (KP)__builtin_amdgcn_kernarg_segment_ptr();
    extern __shared__ __attribute__((aligned(16))) unsigned char lds_raw[];
    LAS unsigned char* lds = (LAS unsigned char*)lds_raw;
    cg::grid_group grid = cg::this_grid();
    const int tid = threadIdx.x, lane = tid & 63, wave = __builtin_amdgcn_readfirstlane(tid >> 6);
    const int G = gridDim.x, bx = blockIdx.x;
    const int gw = bx * 8 + wave, NGW = G * 8;
    const int vgw = ((G & 7) == 0 ? (bx & 7) * (G >> 3) + (bx >> 3) : bx) * 8 + wave;
#define PHASE_VARS asm volatile("" : "+s"(P)); unsigned char* ws = P->ws; float* stats = (float*)(ws + WS_STATS); \
    float* ssq_a = stats, *ssq_s = stats + M, *ln1_sum = stats + 2 * M, *ln1_sq = stats + 3 * M, *ln2_sum = stats + 4 * M, *ln2_sq = stats + 5 * M; \
    (void)ssq_a; (void)ssq_s; (void)ln1_sum; (void)ln1_sq; (void)ln2_sum; (void)ln2_sq;
#ifndef PH_MASK
#define PH_MASK 0x7ff
#endif
#define IN(k) (((PH_MASK >> (k)) & 1) && ph_lo <= (k) && (k) < ph_hi)
#define SEAM(k) do { if (ph_lo <= (k) && (k) + 1 < ph_hi) grid.sync(); } while (0)
    if (IN(0)) { asm volatile("" : "+s"(P)); p0_prep(P, lds, gw, NGW, lane); }
    SEAM(0);
    if (IN(1)) {
        PHASE_VARS
        pg8::Gemm g{(const bf16_t*)(ws + WS_XB), (const bf16_t*)(ws + WS_WIN), D}; pg8::StaticOrder S; S.init(M / 256, NIN / 256, G, bx);
        EpiIn E{(bf16_t*)(ws + WS_Q), (const float*)(ws + WS_ROPEC), (const float*)(ws + WS_ROPES)};
        pg8::gemm_phase<EpiIn, 0>(lds, g, S, E);
    }
    SEAM(1);
    if (IN(2)) {
        PHASE_VARS
        for (int it = bx; it < (M / 512) * 8; it += G) {
            const int bb = it >> 3, h = it & 7;
            const bf16_t* Qp = (const bf16_t*)(ws + WS_Q); const bf16_t* Kp = (const bf16_t*)(ws + WS_K); const bf16_t* Vp = (const bf16_t*)(ws + WS_V);
            for (int j = wave; j < 16; j += 8) attn_tile<1>(Qp, Kp, Vp, (bf16_t*)(ws + WS_MIX), ssq_a, lds, lds + wave * 16384, bb, h, j, lane);
            __syncthreads();
            for (int r = wave; r < 16; r += 8) attn_tile<0>(Qp, Kp, Vp, (bf16_t*)(ws + WS_MIX), ssq_a, lds, lds + wave * 16384, bb, h, r, lane);
            __syncthreads();
        }
        for (int it = vgw; it < (M / (16 * CL)) * 64; it += NGW) ssm_task<0>(P, lds + wave * 16384, it >> 6, it & 31, (it >> 5) & 1, lane);
    }
    SEAM(2);
    if (IN(3)) { asm volatile("" : "+s"(P)); } if (IN(3)) ssm_carry(P, gw * 64 + lane, NGW * 64);
    SEAM(3);
    if (IN(4)) { asm volatile("" : "+s"(P));
        for (int it = vgw; it < (M / (16 * CL)) * 32; it += NGW) {
            ssm_task<1>(P, lds + wave * 16384, it >> 5, it & 31, 0, lane);
            asm volatile("s_waitcnt vmcnt(0)" ::: "memory");
            ssm_task<2>(P, lds + wave * 16384, it >> 5, it & 31, 1, lane);
        }
    }
    SEAM(5);
    if (IN(6)) {
        PHASE_VARS
        pg8::Gemm g{(const bf16_t*)(ws + WS_SPRE), (const bf16_t*)(ws + WS_WGLU), DH}; pg8::StaticOrder S; S.init(M / 256, DH / 256, G, bx);
        EpiGlu E{(const bf16_t*)(ws + WS_SPRE), (bf16_t*)(ws + WS_MIX), P->in[13], ssq_s};
        pg8::gemm_phase<EpiGlu, 2>(lds, g, S, E);
    }
    SEAM(6);
    if (IN(7)) {
        PHASE_VARS
        pg8::Gemm g{(const bf16_t*)(ws + WS_MIX), (const bf16_t*)(ws + WS_WOUT), D}; pg8::StaticOrder S; S.init(M / 256, D / 256, G, bx);
        EpiOut E{P->in[0], P->in[1], P->out, (bf16_t*)(ws + WS_Y1B), ssq_a, ssq_s, ln1_sum, ln1_sq};
        pg8::gemm_phase<EpiOut, 0>(lds, g, S, E);
    }
    SEAM(7);
    if (IN(8)) {
        PHASE_VARS
        pg8::Gemm g{(const bf16_t*)(ws + WS_Y1B) - D, (const bf16_t*)(ws + WS_WUP), D}; pg8::StaticOrder S; S.init(UP_NM, NUP / 256, G, bx);
        EpiUp E{(bf16_t*)(ws + WS_F), (const float*)(ws + WS_GW), (const float*)(ws + WS_BW), P->in[19], P->in[20], ln1_sum, ln1_sq};
        pg8::gemm_phase<EpiUp, 1>(lds, g, S, E);
    }
    SEAM(8);
    if (IN(9)) {
        PHASE_VARS
        pg8::Gemm g{(const bf16_t*)(ws + WS_F), (const bf16_t*)(ws + WS_WDN), FF}; pg8::StaticOrder S; S.init(M / 256, D / 256, G, bx);
        EpiDown E{(const bf16_t*)(ws + WS_Y1B), (bf16_t*)(ws + WS_MIX), P->in[16], P->in[17], ln1_sum, ln1_sq, ln2_sum, ln2_sq};
        pg8::gemm_phase<EpiDown, 0>(lds, g, S, E);
    }
    SEAM(9);
    if (IN(10)) {
        PHASE_VARS
        const float* g2 = P->in[22]; const float* b2 = P->in[23]; const bf16_t* y2b = (const bf16_t*)(ws + WS_MIX); float* outp = P->out;
        for (int row = gw; row < M; row += NGW) {
            const float mu = ln2_sum[row] * (1.0f / D), var = ln2_sq[row] * (1.0f / D) - mu * mu, rstd = __builtin_amdgcn_rsqf(var + LN_EPS);
#pragma unroll
            for (int j = 0; j < 2; ++j) {
                const int col = 512 * j + 8 * lane;
                const u32x4 yv = *(const u32x4*)(y2b + (size_t)row * D + col);
                const f32x4 ya = (f32x4){bf_lo(yv.x), bf_hi(yv.x), bf_lo(yv.y), bf_hi(yv.y)}, yb = (f32x4){bf_lo(yv.z), bf_hi(yv.z), bf_lo(yv.w), bf_hi(yv.w)};
                const f32x4 ga = *(const f32x4*)(g2 + col), gb = *(const f32x4*)(g2 + col + 4), ba = *(const f32x4*)(b2 + col), bb = *(const f32x4*)(b2 + col + 4);
                *(f32x4*)(outp + (size_t)row * D + col) = (ya - mu) * rstd * ga + ba;
                *(f32x4*)(outp + (size_t)row * D + col + 4) = (yb - mu) * rstd * gb + bb;
            }
        }
    }
#undef IN
#undef SEAM
}

extern "C" void kernel_launch(void* const* d_in, const int* in_sizes, int n_in, void* d_out, int out_size, void* d_ws, size_t ws_size, hipStream_t stream) {
    static int grid = 0;
    if (grid == 0) {
        if (n_in != 24 || ws_size < WS_END) { fprintf(stderr, "kernel_launch: unexpected n_in %d / ws_size %zu (need %zu)\n", n_in, ws_size, (size_t)WS_END); grid = -1; return; }
        int dev = 0, cus = 0, per_cu = 0;
        hipGetDevice(&dev); hipDeviceGetAttribute(&cus, hipDeviceAttributeMultiprocessorCount, dev);
        hipFuncSetAttribute((const void*)mega_fwd, hipFuncAttributeMaxDynamicSharedMemorySize, LDS_BYTES);
        hipOccupancyMaxActiveBlocksPerMultiprocessor(&per_cu, (const void*)mega_fwd, 512, LDS_BYTES);
        (void)hipGetLastError();
        if (per_cu < 1) per_cu = 1;
        grid = cus * per_cu;
    }
    if (grid < 0) return;
    Params p{};
    for (int i = 0; i < 24; ++i) p.in[i] = (const float*)d_in[i];
    p.out = (float*)d_out; p.ws = (unsigned char*)d_ws;
    int lo = 0, hi = 11;
    void* args[] = {&p, &lo, &hi};
    hipError_t e = hipLaunchCooperativeKernel((const void*)mega_fwd, dim3(grid), dim3(512), args, LDS_BYTES, stream);
    if (e != hipSuccess) fprintf(stderr, "cooperative launch failed: %s (grid %d)\n", hipGetErrorString(e), grid);
}
```
